# Optimizing an MI355X kernel written in HIP

```python
import jax, jax.numpy as jnp
from jax import lax
import numpy as np

D_MODEL = 1024
BATCH = 32
SEQ = 256
DEPTH = 2
DEC_BATCH = 4
DEC_SEQ = 2048
PAST_LEN = 512

GRID_W = 64
HEAD_DIM = 64
FOURIER_GROUPS = 4
FOURIER_GROUP_W = 64
FOURIER_W = FOURIER_GROUPS * FOURIER_GROUP_W
RET_HEADS = 4
RET_DK = 64
RET_DV = 64
RET_QK_W = RET_HEADS * RET_DK
RET_W = RET_HEADS * RET_DV
RET_CHUNK = 128
ATT_Q_HEADS = 8
ATT_KV_HEADS = 2
ATT_GROUP = ATT_Q_HEADS // ATT_KV_HEADS
ATT_W = ATT_Q_HEADS * HEAD_DIM
ATT_KV_W = ATT_KV_HEADS * HEAD_DIM
WINDOW = 128
ATT_BLOCK = 128
N_BRANCH = 3
ROPE_BASE = 10000.0
EPS = 1e-6
SPLITS = (FOURIER_W, FOURIER_W, RET_QK_W, RET_QK_W, RET_W, RET_W,
          ATT_W, ATT_KV_W, ATT_KV_W, ATT_W, N_BRANCH * D_MODEL)
IN_W = sum(SPLITS)

kernel_name = 'hybrid_fourier_retention_swa_diffusion_step'

F32 = jnp.float32


def rms_norm(x, g):
    xf = x.astype(F32)
    y = xf * lax.rsqrt(jnp.mean(xf * xf, axis=-1, keepdims=True) + EPS)
    return (y * g.astype(F32)).astype(x.dtype)


def split_columns(u):
    parts = []
    start = 0
    for w in SPLITS:
        parts.append(u[..., start:start + w])
        start += w
    return parts


def axial_rope(x):
    n = x.shape[1]
    rows = n // GRID_W
    row = jnp.repeat(jnp.arange(rows), GRID_W)
    col = jnp.tile(jnp.arange(GRID_W), rows)
    quarter = HEAD_DIM // 4
    half = HEAD_DIM // 2
    inv = ROPE_BASE ** (-jnp.arange(quarter, dtype=F32) / quarter)

    def rot(xp, pos):
        ang = pos.astype(F32)[:, None] * inv[None, :]
        cos = jnp.cos(ang)[None, :, None, :]
        sin = jnp.sin(ang)[None, :, None, :]
        x1, x2 = xp[..., :quarter], xp[..., quarter:]
        return jnp.concatenate([x1 * cos - x2 * sin, x1 * sin + x2 * cos], axis=-1)

    xf = x.astype(F32)
    return jnp.concatenate([rot(xf[..., :half], row), rot(xf[..., half:], col)], axis=-1).astype(x.dtype)


def fourier_mix(f):
    b, t, _ = f.shape
    fg = f.astype(F32).reshape(b, t, FOURIER_GROUPS, FOURIER_GROUP_W)
    return jnp.fft.fftn(fg, axes=(1, 3), norm='ortho').real.reshape(b, t, FOURIER_W).astype(f.dtype)


def retention_scan(q, k, v, log_gamma, s0):
    b, t, h, _ = q.shape
    dv = v.shape[-1]
    nc = t // RET_CHUNK

    def chunks(a):
        return jnp.moveaxis(a.astype(F32).reshape(b, nc, RET_CHUNK, h, a.shape[-1]), 1, 0)

    i = jnp.arange(RET_CHUNK, dtype=F32)
    diff = i[:, None] - i[None, :]
    intra = jnp.where(diff[None] >= 0,
                      jnp.exp(jnp.maximum(diff, 0.0)[None] * log_gamma[:, None, None]), 0.0)
    read = jnp.exp((i[:, None] + 1.0) * log_gamma[None, :])
    write = jnp.exp((RET_CHUNK - 1.0 - i)[:, None] * log_gamma[None, :])
    carry_decay = jnp.exp(RET_CHUNK * log_gamma)

    def step(s, qkv):
        qc, kc, vc = qkv
        att = jnp.einsum('bihd,bjhd->bhij', qc, kc) * intra
        o = (jnp.einsum('bhij,bjhe->bihe', att, vc)
             + jnp.einsum('bihd,bhde->bihe', qc, s) * read[None, :, :, None])
        s = carry_decay[None, :, None, None] * s + jnp.einsum(
            'bjhd,bjhe->bhde', kc * write[None, :, :, None], vc)
        return s, o

    s_fin, o = lax.scan(step, s0.astype(F32), (chunks(q), chunks(k), chunks(v)))
    return jnp.moveaxis(o, 0, 1).reshape(b, t, h, dv), s_fin


def bidir_retention(q, k, v, ret_logit, s0_f, s0_b):
    lg = jax.nn.log_sigmoid(ret_logit.astype(F32))
    of, sf = retention_scan(q, k, v, lg[0], s0_f)
    ob, sb = retention_scan(q[:, ::-1], k[:, ::-1], v[:, ::-1], lg[1], s0_b)
    return of + ob[:, ::-1], jnp.stack([sf, sb], axis=1)


def softmax_with_sink(logits, sink):
    s = jnp.broadcast_to(sink.astype(F32)[:, :, None, None], logits.shape[:-1] + (1,))
    p = jax.nn.softmax(jnp.concatenate([logits, s], axis=-1), axis=-1)
    return p[..., :-1]


def context_attention(q, k, v, sink):
    b, l = q.shape[:2]
    nb = l // ATT_BLOCK
    scale = HEAD_DIM ** -0.5
    qb = jnp.moveaxis(q.reshape(b, nb, ATT_BLOCK, ATT_KV_HEADS, ATT_GROUP, HEAD_DIM), 1, 0)
    kf = k.astype(F32)
    vf = v.astype(F32)

    def one(qblk):
        logits = jnp.einsum('bqkgd,bskd->bkgqs', qblk.astype(F32), kf) * scale
        p = softmax_with_sink(logits, sink)
        return jnp.einsum('bkgqs,bskd->bqkgd', p, vf)

    o = lax.map(one, qb)
    return jnp.moveaxis(o, 0, 1).reshape(b, l, ATT_W).astype(q.dtype)


def latent_attention(q, k, v, k_ctx, v_ctx, sink):
    b, n = q.shape[:2]
    blk = ATT_BLOCK
    nb = n // blk
    scale = HEAD_DIM ** -0.5
    qb = q.astype(F32).reshape(b, nb, blk, ATT_KV_HEADS, ATT_GROUP, HEAD_DIM)
    pad = ((0, 0), (blk, blk), (0, 0), (0, 0))
    kp = jnp.pad(k.astype(F32), pad)
    vp = jnp.pad(v.astype(F32), pad)
    band = jnp.arange(nb)[:, None] * blk + jnp.arange(3 * blk)[None, :]
    kb = kp[:, band]
    vb = vp[:, band]
    qpos = jnp.arange(nb)[:, None] * blk + jnp.arange(blk)[None, :]
    kpos = band - blk
    valid = ((jnp.abs(qpos[:, :, None] - kpos[:, None, :]) <= WINDOW)
             & (kpos[:, None, :] >= 0) & (kpos[:, None, :] < n))
    loc = jnp.einsum('bnqkgd,bnskd->bnkgqs', qb, kb) * scale
    loc = jnp.where(valid[None, :, None, None], loc, -jnp.inf)
    ctx = jnp.einsum('bnqkgd,blkd->bnkgql', qb, k_ctx.astype(F32)) * scale
    p = softmax_with_sink(jnp.concatenate([loc, ctx], axis=-1), sink)
    o = (jnp.einsum('bnkgqs,bnskd->bnqkgd', p[..., :3 * blk], vb)
         + jnp.einsum('bnkgql,blkd->bnqkgd', p[..., 3 * blk:], v_ctx.astype(F32)))
    return o.reshape(b, n, ATT_W).astype(q.dtype)


def trunk_layer(x, cvec, w_mod, b_mod, g_pre, g_post, w_in, w_four, ret_logit, ret_gn,
                attn_sink, w_pa, w_pb, w_pc, w_out, k_ctx=None, v_ctx=None, s_ctx=None):
    b, t, _ = x.shape
    is_latent = k_ctx is not None
    mod = (jax.nn.silu(cvec) @ w_mod + b_mod).reshape(-1, 1, 3 * D_MODEL)
    shift, scale, gate = jnp.split(mod, 3, axis=-1)
    h = rms_norm(x, g_pre) * (1.0 + scale) + shift
    fx, fz, rq, rk, rv, rz, aq, ak, av, az, mg = split_columns(h @ w_in)

    ya = (fourier_mix(fx) @ w_four) * jax.nn.silu(fz)

    rq = rq.reshape(b, t, RET_HEADS, RET_DK)
    rk = rk.reshape(b, t, RET_HEADS, RET_DK) * (RET_DK ** -0.5)
    rv = rv.reshape(b, t, RET_HEADS, RET_DV)
    aq = aq.reshape(b, t, ATT_Q_HEADS, HEAD_DIM)
    ak = ak.reshape(b, t, ATT_KV_HEADS, HEAD_DIM)
    av = av.reshape(b, t, ATT_KV_HEADS, HEAD_DIM)
    if is_latent:
        rq, rk = axial_rope(rq), axial_rope(rk)
        aq, ak = axial_rope(aq), axial_rope(ak)
        s0f, s0b = s_ctx[:, 0], s_ctx[:, 1]
    else:
        s0f = s0b = jnp.zeros((b, RET_HEADS, RET_DK, RET_DV), F32)
    ro, s_fin = bidir_retention(rq, rk, rv, ret_logit, s0f, s0b)
    ro = rms_norm(ro, ret_gn.reshape(RET_HEADS, RET_DV)).reshape(b, t, RET_W)
    yb = ro.astype(x.dtype) * jax.nn.silu(rz)

    if is_latent:
        ao = latent_attention(aq, ak, av, k_ctx, v_ctx, attn_sink)
    else:
        ao = context_attention(aq, ak, av, attn_sink)
    yc = ao * jax.nn.silu(az)

    ga, gb, gc = jnp.split(jax.nn.sigmoid(mg), N_BRANCH, axis=-1)
    merged = ga * (ya @ w_pa) + gb * (yb @ w_pb) + gc * (yc @ w_pc)
    out = merged @ w_out
    x = x + gate * rms_norm(out, g_post)
    return x, ak, av, s_fin


def setup_inputs(seed: int = 0) -> dict:
    key = jax.random.key(seed)
    ks = jax.random.split(key, 24)

    def nrm(k, shape, s):
        return jax.random.normal(k, shape, F32) * s

    d = D_MODEL
    base_logit = jnp.asarray(np.log(2.0 ** (5 + np.arange(RET_HEADS)) - 1.0), F32)
    return {
        'x_prompt': nrm(ks[0], (BATCH, SEQ, d), 1.0),
        'x_sample': nrm(ks[1], (DEC_BATCH, DEC_SEQ, d), 1.0),
        'cache_k': nrm(ks[2], (DEC_BATCH, DEPTH, PAST_LEN, ATT_KV_HEADS, HEAD_DIM), 1.0),
        'cache_v': nrm(ks[3], (DEC_BATCH, DEPTH, PAST_LEN, ATT_KV_HEADS, HEAD_DIM), 1.0),
        'state_ret': nrm(ks[4], (DEC_BATCH, DEPTH, 2, RET_HEADS, RET_DK, RET_DV), 1.0),
        'c': nrm(ks[5], (DEC_BATCH, d), 1.0),
        'c_ctx': nrm(ks[6], (d,), 1.0),
        'w_mod': nrm(ks[7], (DEPTH, d, 3 * d), 0.5 * d ** -0.5),
        'b_mod': nrm(ks[8], (DEPTH, 3 * d), 0.02),
        'g_pre': 1.0 + nrm(ks[9], (DEPTH, d), 0.02),
        'g_post': 1.0 + nrm(ks[10], (DEPTH, d), 0.02),
        'w_in': nrm(ks[11], (DEPTH, d, IN_W), d ** -0.5),
        'w_four': nrm(ks[12], (DEPTH, FOURIER_W, FOURIER_W), FOURIER_W ** -0.5),
        'ret_decay': base_logit[None, None, :] + nrm(ks[13], (DEPTH, 2, RET_HEADS), 0.1),
        'ret_gn': 1.0 + nrm(ks[14], (DEPTH, RET_W), 0.02),
        'attn_sink': nrm(ks[15], (DEPTH, ATT_KV_HEADS, ATT_GROUP), 0.5),
        'w_branch_a': nrm(ks[16], (DEPTH, FOURIER_W, d), FOURIER_W ** -0.5),
        'w_branch_b': nrm(ks[17], (DEPTH, RET_W, d), RET_W ** -0.5),
        'w_branch_c': nrm(ks[18], (DEPTH, ATT_W, d), ATT_W ** -0.5),
        'w_out': nrm(ks[19], (DEPTH, d, d), d ** -0.5),
    }


def reference(x_prompt, x_sample, cache_k, cache_v, state_ret, c, c_ctx, w_mod, b_mod,
              g_pre, g_post, w_in, w_four, ret_decay, ret_gn, attn_sink,
              w_branch_a, w_branch_b, w_branch_c, w_out):
    xp = x_prompt
    ks_new, vs_new, ss_new = [], [], []
    for l in range(DEPTH):
        xp, k_l, v_l, s_l = trunk_layer(
            xp, c_ctx, w_mod[l], b_mod[l], g_pre[l], g_post[l], w_in[l], w_four[l],
            ret_decay[l], ret_gn[l], attn_sink[l], w_branch_a[l], w_branch_b[l],
            w_branch_c[l], w_out[l])
        ks_new.append(k_l)
        vs_new.append(v_l)
        ss_new.append(s_l)
    new_cache_k = jnp.stack(ks_new, axis=1)
    new_cache_v = jnp.stack(vs_new, axis=1)
    new_state_ret = jnp.stack(ss_new, axis=1)

    xs = x_sample
    for l in range(DEPTH):
        xs = trunk_layer(
            xs, c, w_mod[l], b_mod[l], g_pre[l], g_post[l], w_in[l], w_four[l],
            ret_decay[l], ret_gn[l], attn_sink[l], w_branch_a[l], w_branch_b[l],
            w_branch_c[l], w_out[l],
            k_ctx=cache_k[:, l], v_ctx=cache_v[:, l], s_ctx=state_ret[:, l])[0]

    return (xp, xs, new_cache_k, new_cache_v, new_state_ret)
```

```cpp
#include <hip/hip_runtime.h>
#include <hip/hip_cooperative_groups.h>
#include <cstdio>
#include <cstdint>
namespace cg = cooperative_groups;

namespace pg8 {
#define PG8_LAS __attribute__((address_space(3)))
typedef unsigned short bf16_t;
typedef short bf16x8 __attribute__((ext_vector_type(8)));
typedef float f32x4 __attribute__((ext_vector_type(4)));
typedef unsigned u32x4 __attribute__((ext_vector_type(4)));
constexpr int BM = 256, BK = 64, HALF = 128, HTB = HALF * BK * 2  , STAGE_BYTES = 8 * HTB, NXCD = 8, WGM = 8;

__host__ __device__ __forceinline__ int lds_byte(int r, int c) { const int st = (r >> 4) * 2 + (c >> 5), rr = r & 15, cc = c & 31, ob = rr * 64 + cc * 2; return st * 1024 + (ob ^ (((ob >> 9) & 1) << 5)); }
__host__ __device__ __forceinline__ void stage_rc(int b, int& R, int& C) { const int st = b / 1024, sb = b % 1024, swz = sb ^ (((sb >> 9) & 1) << 5); R = (st >> 1) * 16 + swz / 64; C = (st & 1) * 32 + (swz % 64) / 2; }
__host__ __device__ __forceinline__ int perm32(int rho) { const int n = rho >> 4, i = rho & 15; return 8 * (i >> 2) + 4 * n + (i & 3); }

struct Unit { int pm, pn; };
struct Gemm { const bf16_t* A; const bf16_t* Bt; int M, N, K; };

struct StaticOrder {
    int nM, nN, nwg, G, c;
    __host__ __device__ void init(int M, int N, int G_, int c_) { nM = M / BM; nN = N / BM; nwg = nM * nN; G = G_; c = c_; }
    __host__ __device__ bool next(int i, Unit& u) const {
        const long L = (long)i * G + c; if (L >= nwg) return false;
        int wgid = (int)L; { const int q = nwg / NXCD, r = nwg % NXCD, xcd = wgid % NXCD, off = wgid / NXCD; wgid = (xcd < r ? xcd * (q + 1) : r * (q + 1) + (xcd - r) * q) + off; }
        const int nig = WGM * nN, gid = wgid / nig, fm = gid * WGM, gsz = (nM - fm) < WGM ? (nM - fm) : WGM;
        u.pm = fm + ((wgid % nig) % gsz); u.pn = (wgid % nig) / gsz; return true;
    }
    __device__ __forceinline__ void a_ready(const Unit&) const {}
    __device__ __forceinline__ void done(const Unit&) const {}
};
__device__ __forceinline__ unsigned cvt_pk_bf16(float lo, float hi) { unsigned r; asm volatile("v_cvt_pk_bf16_f32 %0, %1, %2" : "=v"(r) : "v"(lo), "v"(hi)); return r; }
template <class Epi, class Sched, bool ALIGN_EPI = false, bool SP2 = false>
__device__ __forceinline__ void gemm_phase(PG8_LAS unsigned char* lds, const Gemm g, const Sched& S, const Epi& E) {
    int tid_l = threadIdx.x; asm volatile("" : "+v"(tid_l));
    const int tid = tid_l, wid = __builtin_amdgcn_readfirstlane(tid >> 6), lane = tid & 63, wr = wid >> 2, wc = wid & 3, fr = lane & 15, fq = lane >> 4;
    const int K = g.K, nt = K / BK;
    unsigned voffA[2], voffB[2];
#pragma unroll
    for (int i = 0; i < 2; ++i) { int R, C; stage_rc(tid * 16 + i * 8192, R, C); const int Rb = Epi::PERM ? ((R & ~31) + perm32(R & 31)) : R;
        voffA[i] = (unsigned)(R * K + C) * 2u; voffB[i] = (unsigned)(Rb * K + C) * 2u; }
    const size_t kstep = (size_t)(BK * 2);
    const size_t hstep = (size_t)HALF * K * 2;
    const size_t tstep = 2 * hstep;
    const unsigned ldsw = (unsigned)wid * 1024u;
    const int aoff = lds_byte(wr * 64 + fr, fq * 8), boff = lds_byte(wc * 32 + fr, fq * 8);
#define PG8_SA(b, h) (((b) * 2 + (h)) * HTB)
#define PG8_SB(b, h) ((4 + (b) * 2 + (h)) * HTB)
#define PG8_STAGE(bufoff, gbase, voff) do { _Pragma("unroll") for (int _i = 0; _i < 2; ++_i) \
        __builtin_amdgcn_global_load_lds((const unsigned*)((const char*)(gbase) + (voff)[_i]), (PG8_LAS unsigned*)(lds + (bufoff) + ldsw + _i * 8192), 16, 0, 0); } while (0)
#define PG8_LDA(dst, b, h) do { _Pragma("unroll") for (int m = 0; m < 4; ++m) _Pragma("unroll") for (int k = 0; k < 2; ++k) dst[m][k] = *(const PG8_LAS bf16x8*)(lds + PG8_SA(b, h) + aoff + m * 2048 + k * 1024); } while (0)
#define PG8_LDB(dst, b, h) do { _Pragma("unroll") for (int n = 0; n < 2; ++n) _Pragma("unroll") for (int k = 0; k < 2; ++k) dst[n][k] = *(const PG8_LAS bf16x8*)(lds + PG8_SB(b, h) + boff + n * 2048 + k * 1024); } while (0)
#define PG8_MMA(ai, bj, At, Bt) do { __builtin_amdgcn_s_setprio(1); _Pragma("unroll") for (int m = 0; m < 4; ++m) _Pragma("unroll") for (int n = 0; n < 2; ++n) _Pragma("unroll") for (int k = 0; k < 2; ++k) \
        acc[ai][bj][m][n] = __builtin_amdgcn_mfma_f32_16x16x32_bf16(Bt[n][k], At[m][k], acc[ai][bj][m][n], 0, 0, 0); __builtin_amdgcn_s_setprio(0); } while (0)
#define PG8_WAIT_V(n) asm volatile("s_waitcnt vmcnt(" #n ")" ::: "memory")
#define PG8_WAIT_L(n) asm volatile("s_waitcnt lgkmcnt(" #n ")" ::: "memory")
#define PG8_BAR __builtin_amdgcn_s_barrier()
#define PG8_SCHED __builtin_amdgcn_sched_barrier(0)
    Unit cur, nxt; int ui = 0;
    if (!S.next(0, cur)) return;
    f32x4 acc[2][2][4][2];
#pragma unroll
    for (int a = 0; a < 2; ++a)
#pragma unroll
        for (int b = 0; b < 2; ++b)
#pragma unroll
            for (int m = 0; m < 4; ++m)
#pragma unroll
                for (int n = 0; n < 2; ++n) acc[a][b][m][n] = (f32x4){0.f, 0.f, 0.f, 0.f};
    bf16x8 At[4][2], B0[2][2], B1[2][2];
    const char* cA = (const char*)g.A + (size_t)cur.pm * tstep; const char* cB = (const char*)g.Bt + (size_t)cur.pn * tstep;
    S.a_ready(cur);
    if constexpr (SP2) {
        PG8_STAGE(PG8_SB(0, 0), cB, voffB); PG8_STAGE(PG8_SB(0, 1), cB + hstep, voffB); PG8_STAGE(PG8_SA(0, 0), cA, voffA); PG8_STAGE(PG8_SA(0, 1), cA + hstep, voffA);
        if (wr == 1) PG8_BAR;
        PG8_WAIT_V(2); PG8_BAR;
        PG8_STAGE(PG8_SB(1, 0), cB + kstep, voffB); PG8_STAGE(PG8_SA(1, 0), cA + kstep, voffA); PG8_STAGE(PG8_SB(1, 1), cB + hstep + kstep, voffB);
        PG8_WAIT_V(6); PG8_BAR;
    } else {
        PG8_STAGE(PG8_SB(0, 0), cB, voffB); PG8_STAGE(PG8_SA(0, 0), cA, voffA); PG8_STAGE(PG8_SB(0, 1), cB + hstep, voffB); PG8_STAGE(PG8_SA(0, 1), cA + hstep, voffA);
        if (wr == 1) PG8_BAR;
        PG8_WAIT_V(4); PG8_BAR;
        PG8_STAGE(PG8_SB(1, 0), cB + kstep, voffB); PG8_STAGE(PG8_SA(1, 0), cA + kstep, voffA); PG8_STAGE(PG8_SB(1, 1), cB + hstep + kstep, voffB);
        PG8_WAIT_V(6); PG8_BAR;
    }
    for (;;) {
        const bool has_next = S.next(ui + 1, nxt);
        const char* nA = has_next ? (const char*)g.A + (size_t)nxt.pm * tstep : cA; const char* nB = has_next ? (const char*)g.Bt + (size_t)nxt.pn * tstep : cB;
        for (int t = 0; t < nt; t += 2) {
            if constexpr (Epi::HOOK) { if (t == 4 || t == 8) E.seg(acc, cur, t, wr, wc, fr, fq); }
            const bool last = (t == nt - 2);
            const char* a1 = cA + (size_t)(t + 1) * kstep;
            const char* a2 = last ? nA : cA + (size_t)(t + 2) * kstep; const char* b2 = last ? nB : cB + (size_t)(t + 2) * kstep;
            const char* a3 = a2 + kstep; const char* b3 = b2 + kstep;
            if (last && has_next) S.a_ready(nxt);
            if constexpr (SP2) {
            PG8_LDB(B0, 0, 0); PG8_LDB(B1, 0, 1); PG8_SCHED; PG8_LDA(At, 0, 0); PG8_STAGE(PG8_SA(1, 1), a1 + hstep, voffA);
            PG8_WAIT_V(8); PG8_WAIT_L(0); PG8_BAR; PG8_MMA(0, 0, At, B0); PG8_MMA(0, 1, At, B1); PG8_BAR; PG8_SCHED;
            PG8_LDA(At, 0, 1); PG8_STAGE(PG8_SB(0, 0), b2, voffB); PG8_STAGE(PG8_SB(0, 1), b2 + hstep, voffB); PG8_STAGE(PG8_SA(0, 0), a2, voffA);
            PG8_WAIT_V(8); PG8_WAIT_L(0); PG8_BAR; PG8_MMA(1, 0, At, B0); PG8_MMA(1, 1, At, B1); PG8_BAR; PG8_SCHED;
            PG8_LDB(B0, 1, 0); PG8_LDB(B1, 1, 1); PG8_SCHED; PG8_LDA(At, 1, 0); PG8_STAGE(PG8_SA(0, 1), a2 + hstep, voffA);
            PG8_WAIT_V(8); PG8_WAIT_L(0); PG8_BAR; PG8_MMA(0, 0, At, B0); PG8_MMA(0, 1, At, B1); PG8_BAR; PG8_SCHED;
            PG8_LDA(At, 1, 1); PG8_STAGE(PG8_SB(1, 0), b3, voffB); PG8_STAGE(PG8_SB(1, 1), b3 + hstep, voffB); PG8_STAGE(PG8_SA(1, 0), a3, voffA);
            PG8_WAIT_V(8); PG8_WAIT_L(0); PG8_BAR; PG8_MMA(1, 0, At, B0); PG8_MMA(1, 1, At, B1); PG8_BAR; PG8_SCHED;
            } else {
            PG8_LDB(B0, 0, 0); PG8_SCHED; PG8_LDA(At, 0, 0); PG8_STAGE(PG8_SA(1, 1), a1 + hstep, voffA);
            PG8_WAIT_L(8); PG8_BAR; PG8_WAIT_L(0); PG8_MMA(0, 0, At, B0); PG8_BAR; PG8_SCHED;
            PG8_LDB(B1, 0, 1); PG8_STAGE(PG8_SB(0, 0), b2, voffB);
            PG8_BAR; PG8_WAIT_L(0); PG8_MMA(0, 1, At, B1); PG8_BAR;
            PG8_LDA(At, 0, 1); PG8_STAGE(PG8_SA(0, 0), a2, voffA);
            PG8_BAR; PG8_WAIT_L(0); PG8_MMA(1, 0, At, B0); PG8_BAR; PG8_SCHED;
            PG8_STAGE(PG8_SB(0, 1), b2 + hstep, voffB);
            PG8_WAIT_V(6); PG8_BAR; PG8_MMA(1, 1, At, B1); PG8_BAR;
            PG8_LDB(B0, 1, 0); PG8_SCHED; PG8_LDA(At, 1, 0); PG8_STAGE(PG8_SA(0, 1), a2 + hstep, voffA);
            PG8_WAIT_L(8); PG8_BAR; PG8_WAIT_L(0); PG8_MMA(0, 0, At, B0); PG8_BAR; PG8_SCHED;
            PG8_LDB(B1, 1, 1); PG8_STAGE(PG8_SB(1, 0), b3, voffB);
            PG8_BAR; PG8_WAIT_L(0); PG8_MMA(0, 1, At, B1); PG8_BAR;
            PG8_LDA(At, 1, 1); PG8_STAGE(PG8_SA(1, 0), a3, voffA);
            PG8_BAR; PG8_WAIT_L(0); PG8_MMA(1, 0, At, B0); PG8_BAR; PG8_SCHED;
            PG8_STAGE(PG8_SB(1, 1), b3 + hstep, voffB);
            PG8_WAIT_V(6); PG8_BAR; PG8_MMA(1, 1, At, B1); PG8_BAR;
            }
        }
        if constexpr (ALIGN_EPI) { if (wr == 0) PG8_BAR; }
        if constexpr (!Epi::AFTER_DRAIN) { E(acc, cur, wr, wc, fr, fq); S.done(cur); }
        if (!has_next) break;
#pragma unroll
        for (int a = 0; a < 2; ++a)
#pragma unroll
            for (int b = 0; b < 2; ++b)
#pragma unroll
                for (int m = 0; m < 4; ++m)
#pragma unroll
                    for (int n = 0; n < 2; ++n) acc[a][b][m][n] = (f32x4){0.f, 0.f, 0.f, 0.f};
        cur = nxt; cA = nA; cB = nB; ++ui;
        if constexpr (ALIGN_EPI) { if (wr == 1) PG8_BAR; }
    }
    PG8_WAIT_V(0);
    if constexpr (!ALIGN_EPI) { if (wr == 0) PG8_BAR; }
    PG8_BAR;
    if constexpr (Epi::AFTER_DRAIN) { E.fused(acc, cur, wr, wc, fr, fq, lds, wid, lane); S.done(cur); }
#undef PG8_SA
#undef PG8_SB
#undef PG8_STAGE
#undef PG8_LDA
#undef PG8_LDB
#undef PG8_MMA
#undef PG8_WAIT_V
#undef PG8_WAIT_L
#undef PG8_BAR
#undef PG8_SCHED
}
}

#define DI __device__ __forceinline__
#define LAS __attribute__((address_space(3)))
using pg8::bf16_t; using pg8::bf16x8; using pg8::f32x4; using pg8::Unit;
typedef float f32x16 __attribute__((ext_vector_type(16)));
typedef unsigned u32x4 __attribute__((ext_vector_type(4)));
typedef unsigned u32x2 __attribute__((ext_vector_type(2)));
typedef float f32x2_t __attribute__((ext_vector_type(2)));
typedef __bf16 bf16x2_t __attribute__((ext_vector_type(2)));

constexpr int NTOK = 16384, NCTX = 8192, DM = 1024, NWIN = 6144, WIN_LD = 5888;
constexpr float LOG2E = 1.4426950408889634f;
constexpr float EPS = 1e-6f;
constexpr size_t MiB = 1u << 20;
constexpr size_t WS_CTL = 0, CTL_BYTES = 32768;
constexpr size_t WS_MOD = 1 * MiB;
constexpr size_t WS_LG2 = WS_MOD + 128 * 1024;
constexpr size_t WS_ROPE = WS_LG2 + 256;
constexpr size_t WS_IDENT = WS_ROPE + 8192;
constexpr size_t WS_W4 = 2 * MiB;
constexpr size_t WS_TABC = 3 * MiB;
constexpr size_t WS_CKB = 3 * MiB + 512 * 1024;
constexpr size_t WS_CVT = WS_CKB + 1 * MiB;
constexpr size_t WS_S0T = WS_CVT + 1 * MiB;
constexpr size_t WS_TABL = 6 * MiB;
constexpr size_t WS_WINT = 22 * MiB;
constexpr size_t WS_WBRT = 34 * MiB;
constexpr size_t WS_WOUTT = 36 * MiB;
constexpr size_t WS_H = 38 * MiB;
constexpr size_t WS_UTC = 70 * MiB, WS_UTL = 78 * MiB, WS_FZ = 86 * MiB, WS_RQ = 94 * MiB, WS_RK = 102 * MiB, WS_RVT = 110 * MiB, WS_RZ = 118 * MiB,
                 WS_AQ = 126 * MiB, WS_AK = 142 * MiB, WS_AVT = 146 * MiB, WS_AZ = 150 * MiB, WS_RKTF = 166 * MiB, WS_RKTB = 170 * MiB, WS_MG8 = 174 * MiB, WS_PART = 222 * MiB, WS_RKTFL = 230 * MiB, WS_RKTBL = 234 * MiB, WS_W2 = 238 * MiB, WS_SCH = 254 * MiB, WS_END = 256 * MiB;
constexpr size_t WS_MERGED = 70 * MiB;
constexpr size_t WS_OUT = 102 * MiB;
DI size_t wl(int l) { return l ? (WS_W2 - WS_WINT) : 0; }
constexpr size_t O_Y = 0, O_CK = 16777216, O_CV = 18874368, O_ST = 20971520;
constexpr int LDS_RING = 131072, LDS_STAGE = LDS_RING + 256, STAGE_WAVE = 2560, LDS_BYTES = LDS_STAGE + 8 * STAGE_WAVE;

struct Params {
    const float *x_prompt, *x_sample, *cache_k, *cache_v, *state_ret, *c, *c_ctx, *w_mod, *b_mod, *g_pre, *g_post, *w_in, *w_four, *ret_decay, *ret_gn, *attn_sink,
                *w_pa, *w_pb, *w_pc, *w_out;
    float* out; unsigned char* ws; int ph_lo, ph_hi;
};

DI unsigned pk2(float lo, float hi) { f32x2_t v = {lo, hi}; bf16x2_t b = __builtin_convertvector(v, bf16x2_t); return __builtin_bit_cast(unsigned, b); }
DI bf16_t f2bf(float x) { return (bf16_t)(pk2(x, 0.f) & 0xffffu); }
DI float bflo(unsigned u) { return __uint_as_float(u << 16); }
DI float bfhi(unsigned u) { return __uint_as_float(u & 0xffff0000u); }
DI float silu_f(float v) { return v * __builtin_amdgcn_rcpf(1.f + __expf(-v)); }
DI float sigm_f(float v) { return __builtin_amdgcn_rcpf(1.f + __expf(-v)); }
DI float wave_sum(float v) {
#pragma unroll
    for (int o = 1; o < 64; o <<= 1) v += __shfl_xor(v, o);
    return v;
}
#define LDS_WAIT() asm volatile("s_waitcnt lgkmcnt(0)" ::: "memory")
#define MFMA32(a, b, c) __builtin_amdgcn_mfma_f32_32x32x16_bf16((a), (b), (c), 0, 0, 0)
DI int crow(int reg, int h) { return (reg & 3) + 8 * (reg >> 2) + 4 * h; }

DI size_t fragmajor(int bh, int r, int t) { const size_t blk = (size_t)(bh * 2 + (r >> 5)) * 8 + (t >> 8); const size_t step = blk * 16 + ((t & 255) >> 4); const size_t lane = step * 64 + ((t >> 3) & 1) * 32 + (r & 31); return lane * 8 + (t & 7); }
DI int colperm(int blk) { return (blk >= 2 && blk <= 5) ? (blk ^ 6) : blk; }
struct EpiIn {
    static constexpr bool PERM = true, AFTER_DRAIN = false, HOOK = false;
    unsigned char* ws; float* out; const float* lg2; int layer; LAS unsigned char* stage;
    DI void rope8(float (&v)[8], int t, int wc, int fq) const {
        const float* rc = (const float*)(ws + WS_ROPE); const float* rs = rc + 1024;
        const int pos = (wc & 1) ? (t & 63) : (t >> 6);
        const int i0 = 8 * (fq & 1);
        const f32x4 c_lo = *(const f32x4*)(rc + pos * 16 + i0), c_hi = *(const f32x4*)(rc + pos * 16 + i0 + 4);
        const f32x4 s_lo = *(const f32x4*)(rs + pos * 16 + i0), s_hi = *(const f32x4*)(rs + pos * 16 + i0 + 4);
        const bool second = (fq >> 1) != 0;
#pragma unroll
        for (int e = 0; e < 8; ++e) {
            const float pv = __shfl_xor(v[e], 32);
            const float cs = e < 4 ? c_lo[e & 3] : c_hi[e & 3], sn = e < 4 ? s_lo[e & 3] : s_hi[e & 3];
            v[e] = v[e] * cs + (second ? pv : -pv) * sn;
        }
    }
    DI void tstore(const float (&va)[8], const float (&vb)[8], int fr, int fq, int wid, bf16_t* g, size_t chs) const {
        LAS unsigned char* st = stage + wid * STAGE_WAVE;
#pragma unroll
        for (int e = 0; e < 8; ++e) { *(LAS bf16_t*)(st + (8 * fq + e) * 80 + fr * 2) = f2bf(va[e]); *(LAS bf16_t*)(st + (8 * fq + e) * 80 + (16 + fr) * 2) = f2bf(vb[e]); }
        LDS_WAIT();
        const int lane = fq * 16 + fr;
#pragma unroll
        for (int k = 0; k < 2; ++k) { const int pc = lane + 64 * k, ch = pc >> 2, tp = pc & 3;
            const u32x4 w = *(const LAS u32x4*)(st + ch * 80 + tp * 16);
            *(u32x4*)(g + (size_t)ch * chs + tp * 8) = w; }
        LDS_WAIT();
    }
    template <int BJ, int TYPE, bool LATT>
    DI void tile(const f32x4 (&acc)[2][2][4][2], const Unit& u, int wr, int wc, int fr, int fq) const {
        constexpr int T = LATT ? 2048 : 256;
        const int cb = colperm(u.pn) * 256 + BJ * 128, c0 = cb + wc * 32 + 8 * fq;
        const float* rc = (const float*)(ws + WS_ROPE); const float* rs = rc + 1024;
        if (TYPE == 0 || TYPE == 4 || TYPE == 8 || TYPE == 3) {
            const int wid = wr * 4 + wc;
            const int bq = LATT ? (u.pm - 32) >> 3 : u.pm, tq = LATT ? ((u.pm - 32) & 7) * 256 : 0;
#pragma unroll
            for (int ai = 0; ai < 2; ++ai)
#pragma unroll
                for (int mp = 0; mp < 2; ++mp) {
                    int t0 = tq + ai * 128 + wr * 64 + mp * 32; asm volatile("" : "+s"(t0));
                    float va[8], vb[8];
#pragma unroll
                    for (int e = 0; e < 8; ++e) { va[e] = acc[ai][BJ][2 * mp][e >> 2][e & 3]; vb[e] = acc[ai][BJ][2 * mp + 1][e >> 2][e & 3]; }
                    if (TYPE == 0) {
                        const int seg = cb >= 256 ? 1 : 0, ch0 = cb - seg * 256 + wc * 32;
                        bf16_t* g = LATT ? (bf16_t*)(ws + WS_UTL) + ((size_t)((seg * 2 + (t0 >> 10)) * 1024 + bq * 256 + ch0) * 1024 + (t0 & 1023))
                                         : (bf16_t*)(ws + WS_UTC) + ((size_t)(bq * 256 + ch0) * 512 + seg * 256 + t0);
                        tstore(va, vb, fr, fq, wid, g, LATT ? 1024 : 512);
                    } else if (TYPE == 4) {
                        const int cc0 = cb - 1280 + wc * 32;
                        tstore(va, vb, fr, fq, wid, (bf16_t*)(ws + WS_RVT) + (LATT ? (size_t)2 * 1024 * 1024 : 0) + ((size_t)(bq * 256 + cc0) * T + t0), T);
                    } else if (TYPE == 8) {
                        const int cc0 = cb - 2432 + wc * 32;
                        tstore(va, vb, fr, fq, wid, (bf16_t*)(ws + WS_AVT) + (LATT ? (size_t)1024 * 1024 : 0) + ((size_t)(bq * 128 + cc0) * T + t0), T);
                    } else {
                        const int cc0 = cb - 1024 + wc * 32, hd = cc0 >> 6;
                        const float lf = lg2[layer * 8 + hd], lb = lg2[layer * 8 + 4 + hd];
                        if (LATT) {
                            rope8(va, t0 + fr, wc, fq); rope8(vb, t0 + 16 + fr, wc, fq);
                            bf16_t* d0 = (bf16_t*)(ws + WS_RK) + (size_t)(NCTX + bq * 2048 + t0 + fr) * 256 + cc0 + 8 * fq;
                            u32x4 w; w.x = pk2(va[0] * 0.125f, va[1] * 0.125f); w.y = pk2(va[2] * 0.125f, va[3] * 0.125f); w.z = pk2(va[4] * 0.125f, va[5] * 0.125f); w.w = pk2(va[6] * 0.125f, va[7] * 0.125f);
                            *(u32x4*)d0 = w;
                            w.x = pk2(vb[0] * 0.125f, vb[1] * 0.125f); w.y = pk2(vb[2] * 0.125f, vb[3] * 0.125f); w.z = pk2(vb[4] * 0.125f, vb[5] * 0.125f); w.w = pk2(vb[6] * 0.125f, vb[7] * 0.125f);
                            *(u32x4*)(d0 + 16 * 256) = w;
                        }
                        const float ta = (float)((t0 & 255) + fr), tb = ta + 16.f;
                        const float wfa = 0.125f * __builtin_amdgcn_exp2f((255.f - ta) * lf), wfb = 0.125f * __builtin_amdgcn_exp2f((255.f - tb) * lf);
                        const float ra = __builtin_amdgcn_exp2f(ta * lb - (255.f - ta) * lf), rb = __builtin_amdgcn_exp2f(tb * lb - (255.f - tb) * lf);
#pragma unroll
                        for (int e = 0; e < 8; ++e) { va[e] *= wfa; vb[e] *= wfb; }
                        tstore(va, vb, fr, fq, wid, (bf16_t*)(ws + (LATT ? WS_RKTFL : WS_RKTF)) + ((size_t)(bq * 256 + cc0) * T + t0), T);
#pragma unroll
                        for (int e = 0; e < 8; ++e) { va[e] *= ra; vb[e] *= rb; }
                        tstore(va, vb, fr, fq, wid, (bf16_t*)(ws + (LATT ? WS_RKTBL : WS_RKTB)) + ((size_t)(bq * 256 + cc0) * T + t0), T);
                    }
                    asm volatile("" ::: "memory");
                }
        }
        if (TYPE != 0 && TYPE != 4 && !(TYPE == 3 && LATT))
#pragma unroll
        for (int ai = 0; ai < 2; ++ai)
#pragma unroll
            for (int m = 0; m < 4; ++m) {
                int row = u.pm * 256 + ai * 128 + wr * 64 + m * 16 + fr;
                asm volatile("" : "+v"(row));
                int b, t;
                if (LATT) { const int r2 = row - NCTX; b = r2 >> 11; t = r2 & 2047; } else { b = row >> 8; t = row & 255; }
                float v[8];
#pragma unroll
                for (int e = 0; e < 8; ++e) v[e] = acc[ai][BJ][m][e >> 2][e & 3];
                if (LATT && (TYPE == 2 || TYPE == 6 || TYPE == 7)) rope8(v, t, wc, fq);
                if (TYPE == 0) {
                    const int seg = cb >= 256 ? 1 : 0, ch = c0 - seg * 256;
                    bf16_t* dst = LATT ? (bf16_t*)(ws + WS_UTL) + ((size_t)seg * 4 * 256 * 2048 + (size_t)(b * 256 + ch) * 2048 + t)
                                       : (bf16_t*)(ws + WS_UTC) + ((size_t)(b * 256 + ch) * 512 + seg * 256 + t);
#pragma unroll
                    for (int e = 0; e < 8; ++e) dst[(size_t)e * (LATT ? 2048 : 512)] = f2bf(v[e]);
                } else if (TYPE == 1 || TYPE == 5 || TYPE == 9) {
                    bf16_t* dst = TYPE == 1 ? (bf16_t*)(ws + WS_FZ) + (size_t)row * 256 + (c0 - 512) : TYPE == 5 ? (bf16_t*)(ws + WS_RZ) + (size_t)row * 256 + (c0 - 1536)
                                                                                                                  : (bf16_t*)(ws + WS_AZ) + (size_t)row * 512 + (c0 - 2560);
                    u32x4 w; w.x = pk2(silu_f(v[0]), silu_f(v[1])); w.y = pk2(silu_f(v[2]), silu_f(v[3])); w.z = pk2(silu_f(v[4]), silu_f(v[5])); w.w = pk2(silu_f(v[6]), silu_f(v[7]));
                    *(u32x4*)dst = w;
                } else if (TYPE == 2) {
                    bf16_t* dst = (bf16_t*)(ws + WS_RQ) + (size_t)row * 256 + (c0 - 768);
                    u32x4 w; w.x = pk2(v[0], v[1]); w.y = pk2(v[2], v[3]); w.z = pk2(v[4], v[5]); w.w = pk2(v[6], v[7]);
                    *(u32x4*)dst = w;
                } else if (TYPE == 3) {
                    const int cc = c0 - 1024;
#pragma unroll
                    for (int e = 0; e < 8; ++e) v[e] *= 0.125f;
                    bf16_t* dst = (bf16_t*)(ws + WS_RK) + (size_t)row * 256 + cc;
                    u32x4 w; w.x = pk2(v[0], v[1]); w.y = pk2(v[2], v[3]); w.z = pk2(v[4], v[5]); w.w = pk2(v[6], v[7]);
                    *(u32x4*)dst = w;
                } else if (TYPE == 4) {
                    const int cc = c0 - 1280;
                    bf16_t* dst = (bf16_t*)(ws + WS_RVT) + (LATT ? (size_t)2 * 1024 * 1024 : 0) + ((size_t)(b * 256 + cc) * T + t);
#pragma unroll
                    for (int e = 0; e < 8; ++e) dst[(size_t)e * T] = f2bf(v[e]);
                } else if (TYPE == 6) {
                    bf16_t* dst = (bf16_t*)(ws + WS_AQ) + (size_t)row * 512 + (c0 - 1792);
                    u32x4 w; constexpr float QS = 0.125f * LOG2E; w.x = pk2(v[0] * QS, v[1] * QS); w.y = pk2(v[2] * QS, v[3] * QS); w.z = pk2(v[4] * QS, v[5] * QS); w.w = pk2(v[6] * QS, v[7] * QS);
                    *(u32x4*)dst = w;
                } else if (TYPE == 7) {
                    const int cc = c0 - 2304;
                    bf16_t* dst = (bf16_t*)(ws + WS_AK) + (size_t)row * 128 + cc;
                    u32x4 w; w.x = pk2(v[0], v[1]); w.y = pk2(v[2], v[3]); w.z = pk2(v[4], v[5]); w.w = pk2(v[6], v[7]);
                    *(u32x4*)dst = w;
                    if (!LATT) { float* o = out + O_CK + ((size_t)((b * 2 + layer) * 256 + t) * 128 + cc);
                        *(f32x4*)o = (f32x4){v[0], v[1], v[2], v[3]}; *(f32x4*)(o + 4) = (f32x4){v[4], v[5], v[6], v[7]}; }
                } else if (TYPE == 8) {
                    const int cc = c0 - 2432;
                    if (!LATT) { float* o = out + O_CV + ((size_t)((b * 2 + layer) * 256 + t) * 128 + cc);
                        *(f32x4*)o = (f32x4){v[0], v[1], v[2], v[3]}; *(f32x4*)(o + 4) = (f32x4){v[4], v[5], v[6], v[7]}; }
                } else {
                    unsigned q[8];
#pragma unroll
                    for (int e = 0; e < 8; ++e) { float g = rintf(sigm_f(v[e]) * 255.f); g = fminf(fmaxf(g, 1.f), 255.f); q[e] = (unsigned)g; }
                    u32x2 w; w.x = q[0] | (q[1] << 8) | (q[2] << 16) | (q[3] << 24); w.y = q[4] | (q[5] << 8) | (q[6] << 16) | (q[7] << 24);
                    *(u32x2*)(ws + WS_MG8 + (size_t)row * 3072 + (c0 - 3072)) = w;
                }
                asm volatile("" ::: "memory");
            }
    }
    template <int BJ, bool LATT>
    DI void tile_bj(const f32x4 (&acc)[2][2][4][2], const Unit& u, int wr, int wc, int fr, int fq) const {
        const int cb = colperm(u.pn) * 256 + BJ * 128;
        if (cb >= 3072) tile<BJ, 10, LATT>(acc, u, wr, wc, fr, fq);
        else if (cb < 512) tile<BJ, 0, LATT>(acc, u, wr, wc, fr, fq);
        else if (cb < 768) tile<BJ, 1, LATT>(acc, u, wr, wc, fr, fq);
        else if (cb < 1024) tile<BJ, 2, LATT>(acc, u, wr, wc, fr, fq);
        else if (cb < 1280) tile<BJ, 3, LATT>(acc, u, wr, wc, fr, fq);
        else if (cb < 1536) tile<BJ, 4, LATT>(acc, u, wr, wc, fr, fq);
        else if (cb < 1792) tile<BJ, 5, LATT>(acc, u, wr, wc, fr, fq);
        else if (cb < 2304) tile<BJ, 6, LATT>(acc, u, wr, wc, fr, fq);
        else if (cb < 2432) tile<BJ, 7, LATT>(acc, u, wr, wc, fr, fq);
        else if (cb < 2560) tile<BJ, 8, LATT>(acc, u, wr, wc, fr, fq);
        else tile<BJ, 9, LATT>(acc, u, wr, wc, fr, fq);
    }
    DI void operator()(const f32x4 (&acc)[2][2][4][2], const Unit& u, int wr, int wc, int fr_, int fq_) const {
        int fr = fr_, fq = fq_; asm volatile("" : "+v"(fr), "+v"(fq));
        if (u.pm >= 32) { tile_bj<0, true>(acc, u, wr, wc, fr, fq); tile_bj<1, true>(acc, u, wr, wc, fr, fq); }
        else { tile_bj<0, false>(acc, u, wr, wc, fr, fq); tile_bj<1, false>(acc, u, wr, wc, fr, fq); }
    }
};

struct EpiDft {
    static constexpr bool PERM = true, AFTER_DRAIN = false, HOOK = false;
    const bf16_t* FZ; bf16_t* Y; int tokbase, T;
    DI void operator()(const f32x4 (&acc)[2][2][4][2], const Unit& u, int wr, int wc, int fr_, int fq_) const {
        int fr = fr_, fq = fq_; asm volatile("" : "+v"(fr), "+v"(fq));
#pragma unroll
        for (int ai = 0; ai < 2; ++ai)
#pragma unroll
            for (int m = 0; m < 4; ++m) {
                const size_t tok = (size_t)tokbase + (size_t)u.pn * T + u.pm * 256 + ai * 128 + wr * 64 + m * 16 + fr;
#pragma unroll
                for (int bj = 0; bj < 2; ++bj) {
                    const int col = bj * 128 + wc * 32 + 8 * fq;
                    const u32x4 z = *(const u32x4*)(FZ + tok * 256 + col);
                    const f32x4 a0 = acc[ai][bj][m][0], a1 = acc[ai][bj][m][1];
                    u32x4 w; w.x = pk2(a0[0] * bflo(z.x), a0[1] * bfhi(z.x)); w.y = pk2(a0[2] * bflo(z.y), a0[3] * bfhi(z.y));
                    w.z = pk2(a1[0] * bflo(z.z), a1[1] * bfhi(z.z)); w.w = pk2(a1[2] * bflo(z.w), a1[3] * bfhi(z.w));
                    *(u32x4*)(Y + tok * 1024 + col) = w;
                }
            }
    }
};

struct EpiDftHalf {
    static constexpr bool PERM = true, AFTER_DRAIN = true, HOOK = false;
    const bf16_t* FZ; bf16_t* Y; bf16_t* PART; unsigned* cnt; int half;
    DI void fused(const f32x4 (&acc)[2][2][4][2], const Unit& u, int wr, int wc, int fr_, int fq_, LAS unsigned char* lds, int wid, int lane) const {
        int fr = fr_, fq = fq_; asm volatile("" : "+v"(fr), "+v"(fq));
        const int tid = wid * 64 + lane, tile = u.pn * 4 + u.pm;
        u32x2* mine = (u32x2*)PART + (size_t)(tile * 4 + half) * 32 * 512 + tid;
#pragma unroll
        for (int ai = 0; ai < 2; ++ai)
#pragma unroll
            for (int bj = 0; bj < 2; ++bj)
#pragma unroll
                for (int m = 0; m < 4; ++m)
#pragma unroll
                    for (int n = 0; n < 2; ++n) { const f32x4 a = acc[ai][bj][m][n]; mine[(size_t)((((ai * 2 + bj) * 4 + m) * 2 + n)) * 512] = (u32x2){pk2(a[0], a[1]), pk2(a[2], a[3])}; }
        asm volatile("s_waitcnt vmcnt(0)" ::: "memory");
        __syncthreads();
        volatile LAS unsigned* flag = (volatile LAS unsigned*)(lds + 64);
        if (tid == 0) {
            __builtin_amdgcn_fence(__ATOMIC_RELEASE, "agent"); asm volatile("s_waitcnt vmcnt(0)" ::: "memory");
            const unsigned old = __hip_atomic_fetch_add(cnt + tile, 1u, __ATOMIC_RELAXED, __HIP_MEMORY_SCOPE_AGENT);
            if (old == 3u) { __builtin_amdgcn_fence(__ATOMIC_ACQUIRE, "agent"); asm volatile("s_waitcnt vmcnt(0)" ::: "memory"); }
            flag[0] = old;
        }
        __syncthreads();
        if (flag[0] != 3u) return;
        const float sm = half < 2 ? 1.f : -1.f;
        const u32x2* o1p = (const u32x2*)PART + (size_t)(tile * 4 + ((half + 1) & 3)) * 32 * 512 + tid; const float s1 = ((half + 1) & 3) < 2 ? 1.f : -1.f;
        const u32x2* o2p = (const u32x2*)PART + (size_t)(tile * 4 + ((half + 2) & 3)) * 32 * 512 + tid; const float s2 = ((half + 2) & 3) < 2 ? 1.f : -1.f;
        const u32x2* o3p = (const u32x2*)PART + (size_t)(tile * 4 + ((half + 3) & 3)) * 32 * 512 + tid; const float s3 = ((half + 3) & 3) < 2 ? 1.f : -1.f;
#pragma unroll
        for (int ai = 0; ai < 2; ++ai)
#pragma unroll
            for (int m = 0; m < 4; ++m) {
                int k = u.pm * 256 + ai * 128 + wr * 64 + m * 16 + fr; asm volatile("" : "+v"(k));
                const size_t tok = (size_t)NCTX + (size_t)u.pn * 2048 + k;
                const size_t tokm = (size_t)NCTX + (size_t)u.pn * 2048 + (k ? 2048 - k : 0);
#pragma unroll
                for (int bj = 0; bj < 2; ++bj) {
                    const int col = bj * 128 + wc * 32 + 8 * fq;
                    const u32x4 z = *(const u32x4*)(FZ + tok * 256 + col);
                    const u32x4 zm = *(const u32x4*)(FZ + tokm * 256 + col);
                    f32x4 a[2], d[2];
#pragma unroll
                    for (int n = 0; n < 2; ++n) {
                        const size_t ix = (size_t)((((ai * 2 + bj) * 4 + m) * 2 + n)) * 512;
                        const u32x2 q1 = o1p[ix], q2 = o2p[ix], q3 = o3p[ix];
                        const f32x4 p1 = (f32x4){bflo(q1.x), bfhi(q1.x), bflo(q1.y), bfhi(q1.y)}, p2 = (f32x4){bflo(q2.x), bfhi(q2.x), bflo(q2.y), bfhi(q2.y)},
                                    p3 = (f32x4){bflo(q3.x), bfhi(q3.x), bflo(q3.y), bfhi(q3.y)};
                        a[n] = (acc[ai][bj][m][n] + p1) + (p2 + p3);
                        d[n] = (acc[ai][bj][m][n] * sm + p1 * s1) + (p2 * s2 + p3 * s3);
                    }
                    u32x4 w; w.x = pk2(a[0][0] * bflo(z.x), a[0][1] * bfhi(z.x)); w.y = pk2(a[0][2] * bflo(z.y), a[0][3] * bfhi(z.y));
                    w.z = pk2(a[1][0] * bflo(z.z), a[1][1] * bfhi(z.z)); w.w = pk2(a[1][2] * bflo(z.w), a[1][3] * bfhi(z.w));
                    *(u32x4*)(Y + tok * 1024 + col) = w;
                    if (k != 0) {
                        u32x4 wm; wm.x = pk2(d[0][0] * bflo(zm.x), d[0][1] * bfhi(zm.x)); wm.y = pk2(d[0][2] * bflo(zm.y), d[0][3] * bfhi(zm.y));
                        wm.z = pk2(d[1][0] * bflo(zm.z), d[1][1] * bfhi(zm.z)); wm.w = pk2(d[1][2] * bflo(zm.w), d[1][3] * bfhi(zm.w));
                        *(u32x4*)(Y + tokm * 1024 + col) = wm;
                    }
                }
                asm volatile("" ::: "memory");
            }
    }
};

struct EpiMerge {
    static constexpr bool PERM = true, AFTER_DRAIN = false, HOOK = true;
    const unsigned char* MG8; bf16_t* MERGED;
    DI void seg(f32x4 (&acc)[2][2][4][2], const Unit& u, int t, int wr, int wc, int fr_, int fq_) const {
        int fr = fr_, fq = fq_; asm volatile("" : "+v"(fr), "+v"(fq));
        const int which = (t == 4) ? 0 : 1;
#pragma unroll
        for (int ai = 0; ai < 2; ++ai)
#pragma unroll
            for (int m = 0; m < 4; ++m) {
                const size_t row = (size_t)u.pm * 256 + ai * 128 + wr * 64 + m * 16 + fr;
#pragma unroll
                for (int bj = 0; bj < 2; ++bj) {
                    const int col = u.pn * 256 + bj * 128 + wc * 32 + 8 * fq;
                    const u32x2 ga = *(const u32x2*)(MG8 + row * 3072 + which * 1024 + col);
                    const u32x2 gb = *(const u32x2*)(MG8 + row * 3072 + (which + 1) * 1024 + col);
#pragma unroll
                    for (int e = 0; e < 8; ++e) {
                        const unsigned wa = e < 4 ? ga.x : ga.y, wb = e < 4 ? gb.x : gb.y;
                        const float fa = (float)((wa >> (8 * (e & 3))) & 255u), fb = (float)((wb >> (8 * (e & 3))) & 255u);
                        acc[ai][bj][m][e >> 2][e & 3] *= fa * __builtin_amdgcn_rcpf(fb);
                    }
                }
            }
    }
    DI void operator()(const f32x4 (&acc)[2][2][4][2], const Unit& u, int wr, int wc, int fr_, int fq_) const {
        int fr = fr_, fq = fq_; asm volatile("" : "+v"(fr), "+v"(fq));
#pragma unroll
        for (int ai = 0; ai < 2; ++ai)
#pragma unroll
            for (int m = 0; m < 4; ++m) {
                const size_t row = (size_t)u.pm * 256 + ai * 128 + wr * 64 + m * 16 + fr;
#pragma unroll
                for (int bj = 0; bj < 2; ++bj) {
                    const int col = u.pn * 256 + bj * 128 + wc * 32 + 8 * fq;
                    const u32x2 gc = *(const u32x2*)(MG8 + row * 3072 + 2048 + col);
                    float r[8];
#pragma unroll
                    for (int e = 0; e < 8; ++e) { const unsigned wcw = e < 4 ? gc.x : gc.y; r[e] = acc[ai][bj][m][e >> 2][e & 3] * ((float)((wcw >> (8 * (e & 3))) & 255u) * (1.f / 255.f)); }
                    u32x4 w; w.x = pk2(r[0], r[1]); w.y = pk2(r[2], r[3]); w.z = pk2(r[4], r[5]); w.w = pk2(r[6], r[7]);
                    *(u32x4*)(MERGED + row * 1024 + col) = w;
                }
            }
    }
};

struct EpiOut {
    static constexpr bool PERM = true, AFTER_DRAIN = false, HOOK = false;
    bf16_t* OUT;
    DI void operator()(const f32x4 (&acc)[2][2][4][2], const Unit& u, int wr, int wc, int fr_, int fq_) const {
        int fr = fr_, fq = fq_; asm volatile("" : "+v"(fr), "+v"(fq));
#pragma unroll
        for (int ai = 0; ai < 2; ++ai)
#pragma unroll
            for (int m = 0; m < 4; ++m) {
                const size_t row = (size_t)u.pm * 256 + ai * 128 + wr * 64 + m * 16 + fr;
#pragma unroll
                for (int bj = 0; bj < 2; ++bj) {
                    const int col = u.pn * 256 + bj * 128 + wc * 32 + 8 * fq;
                    const f32x4 a0 = acc[ai][bj][m][0], a1 = acc[ai][bj][m][1];
                    u32x4 w; w.x = pk2(a0[0], a0[1]); w.y = pk2(a0[2], a0[3]); w.z = pk2(a1[0], a1[1]); w.w = pk2(a1[2], a1[3]);
                    *(u32x4*)(OUT + row * 1024 + col) = w;
                }
            }
    }
};

struct OneUnit {
    Unit u;
    DI bool next(int i, Unit& o) const { if (i != 0) return false; o = u; return true; }
    DI void a_ready(const Unit&) const {}
    DI void done(const Unit&) const {}
};

DI void phase0(const Params& p, LAS unsigned char* lds) {
    const int tid = threadIdx.x, G = gridDim.x, bid = blockIdx.x;
    const size_t gtid = (size_t)bid * 512 + tid, gsz = (size_t)G * 512;
    unsigned char* ws = p.ws;
    LAS float* ctab = (LAS float*)lds;
    LAS float* sc = (LAS float*)(lds + 8192);
    LAS float* red = (LAS float*)(lds + 8192 + 20480);
    for (int j = tid; j < 2048; j += 512) ctab[j] = cosf((float)j * (6.283185307179586f / 2048.f));
    for (int i = tid; i < 5120; i += 512) { const int v = i >> 10, k = i & 1023; const float x = v == 0 ? p.c_ctx[k] : p.c[(v - 1) * 1024 + k]; sc[i] = x / (1.f + expf(-x)); }
    __syncthreads();
    if (gtid < 16) { const float x = p.ret_decay[gtid]; ((float*)(ws + WS_LG2))[gtid] = -log1pf(expf(-x)) * LOG2E; }
    for (size_t i = gtid; i < 1024; i += gsz) { const int pos = (int)(i >> 4), k = (int)(i & 15); const float inv = powf(10000.f, -(float)k / 16.f), ang = (float)pos * inv;
        ((float*)(ws + WS_ROPE))[i] = cosf(ang); ((float*)(ws + WS_ROPE))[1024 + i] = sinf(ang); }
    for (size_t i = gtid; i < 4096; i += gsz) ((bf16_t*)(ws + WS_IDENT))[i] = ((i >> 6) == (i & 63)) ? (bf16_t)0x3F80 : (bf16_t)0;
    for (size_t i = gtid; i < (size_t)2 * 2 * 65536; i += gsz) {
        const int n = (int)(i & 255), r = (int)((i >> 8) & 255), x = (int)((i >> 16) & 1), l = (int)(i >> 17);
        const int grp = r >> 6, rr = r & 63; const float* wf = p.w_four + ((size_t)l * 256 + grp * 64) * 256 + n; float s = 0.f;
        for (int m = 0; m < 64; ++m) { const int a = (rr * m) & 63; const float tr = x == 0 ? ctab[a * 32] : ctab[((a * 32) - 512) & 2047]; s += tr * wf[(size_t)m * 256]; }
        ((float*)(ws + WS_W4))[i] = s * 0.125f;
    }
    for (int it = bid; it < 192; it += G) {
        const int l = it / 96, cg0 = (it % 96) * 32, ks = tid >> 5, col = tid & 31;
        float a[5] = {0.f, 0.f, 0.f, 0.f, 0.f};
        const float* wp = p.w_mod + ((size_t)l * 1024 + ks * 64) * 3072 + cg0 + col;
#pragma unroll 1
        for (int k8 = 0; k8 < 64; k8 += 8) { float wv[8];
#pragma unroll
            for (int q = 0; q < 8; ++q) wv[q] = wp[(size_t)(k8 + q) * 3072];
#pragma unroll
            for (int q = 0; q < 8; ++q)
#pragma unroll
                for (int v = 0; v < 5; ++v) a[v] += sc[v * 1024 + ks * 64 + k8 + q] * wv[q]; }
        __syncthreads();
#pragma unroll
        for (int v = 0; v < 5; ++v) red[(ks * 5 + v) * 32 + col] = a[v];
        __syncthreads();
        if (tid < 160) { const int v = tid >> 5; float s = 0.f;
#pragma unroll
            for (int k2 = 0; k2 < 16; ++k2) s += red[(k2 * 5 + v) * 32 + col];
            ((float*)(ws + WS_MOD))[((size_t)l * 5 + v) * 3072 + cg0 + col] = s + p.b_mod[(size_t)l * 3072 + cg0 + col]; }
    }
}

DI void phase0b(const Params& p, LAS unsigned char* lds) {
    int tid_l = threadIdx.x; asm volatile("" : "+v"(tid_l));
    const int tid = tid_l, G = gridDim.x, bid = blockIdx.x;
    const size_t gtid = (size_t)bid * 512 + tid, gsz = (size_t)G * 512;
    unsigned char* ws = p.ws;
    LAS float* ctab = (LAS float*)lds;
    __syncthreads();
    for (int j = tid; j < 2048; j += 512) ctab[j] = cosf((float)j * (6.283185307179586f / 2048.f));
    __syncthreads();
    for (size_t i = gtid; i < (size_t)256 * 512 / 8; i += gsz) {
        const int k = (int)(i >> 6), t0 = (int)(i & 63) * 8; unsigned w[4];
#pragma unroll
        for (int e = 0; e < 8; e += 2) { float v2[2];
#pragma unroll
            for (int q = 0; q < 2; ++q) { const int tp = t0 + e + q, seg = tp >> 8, t = tp & 255, a = ((k * t) & 255) * 8; v2[q] = (seg ? -ctab[(a - 512) & 2047] : ctab[a]) * 0.0625f; }
            w[e >> 1] = pk2(v2[0], v2[1]); }
        *(u32x4*)((bf16_t*)(ws + WS_TABC) + i * 8) = (u32x4){w[0], w[1], w[2], w[3]};
    }
    for (size_t i = gtid; i < (size_t)4 * 1024 * 1024 / 8; i += gsz) {
        const int part = (int)(i >> 17), k = (int)((i >> 7) & 1023), t0 = (int)(i & 127) * 8 + (part & 1) * 1024, seg = part >> 1; unsigned w[4];
#pragma unroll
        for (int e = 0; e < 8; e += 2) { float v2[2];
#pragma unroll
            for (int q = 0; q < 2; ++q) { const int t = t0 + e + q, a = (k * t) & 2047; v2[q] = (seg ? -ctab[(a - 512) & 2047] : ctab[a]) * 0.02209708691207961f; }
            w[e >> 1] = pk2(v2[0], v2[1]); }
        *(u32x4*)((bf16_t*)(ws + WS_TABL) + i * 8) = (u32x4){w[0], w[1], w[2], w[3]};
    }
    for (size_t i = gtid; i < (size_t)2 * 4 * 2 * 512 * 64; i += gsz) {
        const int d = (int)(i & 63), s = (int)((i >> 6) & 511), kvh = (int)((i >> 15) & 1), b = (int)((i >> 16) & 3), l = (int)(i >> 18);
        const size_t src = ((((size_t)b * 2 + l) * 512 + s) * 2 + kvh) * 64 + d;
        ((bf16_t*)(ws + WS_CKB))[i] = f2bf(p.cache_k[src]);
        ((bf16_t*)(ws + WS_CVT))[((((size_t)l * 4 + b) * 2 + kvh) * 64 + d) * 512 + s] = f2bf(p.cache_v[src]);
    }
    __syncthreads();
}

DI void transpose_item(const float* src, int ld_src, bf16_t* dst, int ld_dst, int k0, int n0src, int rowdst0, int kdst0, LAS float* scr, int lane) {
#pragma unroll 8
    for (int i = 0; i < 32; ++i) { const int kk = 2 * i + (lane >> 5); scr[kk * 33 + (lane & 31)] = src[(size_t)(k0 + kk) * ld_src + n0src + (lane & 31)]; }
    LDS_WAIT();
    const int c = lane & 7;
#pragma unroll
    for (int j = 0; j < 4; ++j) { const int n = (lane >> 3) + 8 * j; const LAS float* s = scr + (8 * c) * 33 + n;
        u32x4 o; o.x = pk2(s[0 * 33], s[1 * 33]); o.y = pk2(s[2 * 33], s[3 * 33]); o.z = pk2(s[4 * 33], s[5 * 33]); o.w = pk2(s[6 * 33], s[7 * 33]);
        *(u32x4*)(dst + (size_t)(rowdst0 + n) * ld_dst + kdst0 + 8 * c) = o; }
    LDS_WAIT();
}

DI void row_pass(const Params& p, int mode) {
    int tid_l = threadIdx.x; asm volatile("" : "+v"(tid_l));
    const int lane = tid_l & 63, wave = __builtin_amdgcn_readfirstlane(tid_l >> 6);
    const int gw = blockIdx.x * 8 + wave, NGW = gridDim.x * 8;
    const float* mod = (const float*)(p.ws + WS_MOD);
    for (int row = gw; row < NTOK; row += NGW) {
        const bool lat = row >= NCTX; const int vec = lat ? 1 + ((row - NCTX) >> 11) : 0;
        const float* xin = mode == 2 ? p.out + (size_t)row * 1024 : (lat ? p.x_sample + (size_t)(row - NCTX) * 1024 : p.x_prompt + (size_t)row * 1024);
        f32x4 x[4];
        if (mode == 2) {
            const bf16_t* xb = (const bf16_t*)xin;
#pragma unroll
            for (int j = 0; j < 4; ++j) { const u32x2 v = *(const u32x2*)(xb + 4 * lane + 256 * j); x[j] = (f32x4){bflo(v.x), bfhi(v.x), bflo(v.y), bfhi(v.y)}; }
        } else {
#pragma unroll
            for (int j = 0; j < 4; ++j) x[j] = *(const f32x4*)(xin + 4 * lane + 256 * j);
        }
        if (mode != 0) {
            const int lp = mode - 1;
            const bf16_t* orow = (const bf16_t*)(p.ws + WS_OUT) + (size_t)row * 1024;
            f32x4 o[4]; float s = 0.f;
#pragma unroll
            for (int j = 0; j < 4; ++j) { const u32x2 ob = *(const u32x2*)(orow + 4 * lane + 256 * j); o[j] = (f32x4){bflo(ob.x), bfhi(ob.x), bflo(ob.y), bfhi(ob.y)};
                s += (o[j][0] * o[j][0] + o[j][1] * o[j][1]) + (o[j][2] * o[j][2] + o[j][3] * o[j][3]); }
            const float rstd = 1.f / sqrtf(wave_sum(s) * (1.f / 1024.f) + EPS);
#pragma unroll
            for (int j = 0; j < 4; ++j) {
                const f32x4 gp = *(const f32x4*)(p.g_post + (size_t)lp * 1024 + 4 * lane + 256 * j);
                const f32x4 gt = *(const f32x4*)(mod + ((size_t)lp * 5 + vec) * 3072 + 2048 + 4 * lane + 256 * j);
                x[j] = x[j] + gt * (o[j] * rstd * gp);
                if (mode == 2) *(f32x4*)(p.out + (size_t)row * 1024 + 4 * lane + 256 * j) = x[j];
                else { u32x2 w; w.x = pk2(x[j][0], x[j][1]); w.y = pk2(x[j][2], x[j][3]); *(u32x2*)((bf16_t*)(p.out + (size_t)row * 1024) + 4 * lane + 256 * j) = w; }
            }
        }
        if (mode != 2) {
            const int l = mode; float s = 0.f;
#pragma unroll
            for (int j = 0; j < 4; ++j) s += (x[j][0] * x[j][0] + x[j][1] * x[j][1]) + (x[j][2] * x[j][2] + x[j][3] * x[j][3]);
            const float rstd = 1.f / sqrtf(wave_sum(s) * (1.f / 1024.f) + EPS);
            bf16_t* hrow = (bf16_t*)(p.ws + WS_H) + (size_t)row * 1024;
#pragma unroll
            for (int j = 0; j < 4; ++j) {
                const f32x4 g = *(const f32x4*)(p.g_pre + (size_t)l * 1024 + 4 * lane + 256 * j);
                const f32x4 sh = *(const f32x4*)(mod + ((size_t)l * 5 + vec) * 3072 + 4 * lane + 256 * j);
                const f32x4 scl = *(const f32x4*)(mod + ((size_t)l * 5 + vec) * 3072 + 1024 + 4 * lane + 256 * j);
                const f32x4 hv = (x[j] * rstd * g) * (scl + 1.f) + sh;
                u32x2 w; w.x = pk2(hv[0], hv[1]); w.y = pk2(hv[2], hv[3]);
                *(u32x2*)(hrow + 4 * lane + 256 * j) = w;
            }
        }
    }
}

DI void weight_prep(const Params& p, LAS unsigned char* lds, bool do_fold, bool do_tr) {
    int tid_l = threadIdx.x; asm volatile("" : "+v"(tid_l));
    const int tid = tid_l, lane = tid & 63, wave = __builtin_amdgcn_readfirstlane(tid >> 6), G = gridDim.x;
    unsigned char* ws = p.ws;
    LAS float* sA = (LAS float*)lds; LAS float* sB = sA + 64 * 129;
    if (do_fold)
    for (int it0 = blockIdx.x; it0 < 256; it0 += G) {
        const int l = it0 >> 7, it = it0 & 127; bf16_t* WinT = (bf16_t*)(ws + WS_WINT + wl(l));
        const int dt = it >> 3, nt8 = it & 7, x = nt8 >> 2, n0 = (nt8 & 3) * 64;
        const float* W4 = (const float*)(ws + WS_W4) + ((size_t)l * 2 + x) * 65536;
        const float* wi = p.w_in + (size_t)l * 1024 * WIN_LD + (size_t)dt * 64 * WIN_LD;
        float a[8] = {0.f, 0.f, 0.f, 0.f, 0.f, 0.f, 0.f, 0.f};
        const int d = tid >> 3, ng = tid & 7;
        for (int half = 0; half < 2; ++half) {
            __syncthreads();
            for (int i = tid; i < 8192; i += 512) { const int dd = i >> 7, r = i & 127; sA[dd * 129 + r] = wi[(size_t)dd * WIN_LD + half * 128 + r]; }
            for (int i = tid; i < 8192; i += 512) { const int r = i >> 6, n = i & 63; sB[r * 64 + n] = W4[(size_t)(half * 128 + r) * 256 + n0 + n]; }
            __syncthreads();
            for (int r = 0; r < 128; ++r) { const float av = sA[d * 129 + r]; const LAS float* bp = sB + r * 64 + ng * 8;
#pragma unroll
                for (int e = 0; e < 8; ++e) a[e] += av * bp[e]; }
        }
#pragma unroll
        for (int e = 0; e < 8; ++e) WinT[(size_t)(x * 256 + n0 + ng * 8 + e) * 1024 + dt * 64 + d] = f2bf(a[e]);
    }
    __syncthreads();
    LAS float* scr = (LAS float*)(lds + wave * 8704);
    const int gw = blockIdx.x * 8 + wave, NGW = G * 8;
    if (do_tr)
    for (int it = gw; it < 7680; it += NGW) {
        const int l = it / 3840; int r = it % 3840; bf16_t* WinT = (bf16_t*)(ws + WS_WINT + wl(l));
        if (r < 2816) { const int kb = r / 176, nb = r % 176; const int lrow = 512 + 32 * nb, prow = colperm(lrow >> 8) * 256 + (lrow & 255); transpose_item(p.w_in + (size_t)l * 1024 * WIN_LD, WIN_LD, WinT, 1024, 64 * kb, 256 + 32 * nb, prow, 64 * kb, scr, lane); continue; } r -= 2816;
        if (r < 128) { const int kb = r >> 5, nb = r & 31; transpose_item(p.w_pa + (size_t)l * 256 * 1024, 1024, (bf16_t*)(ws + WS_WBRT + wl(l)), 1024, 64 * kb, 32 * nb, 32 * nb, 64 * kb, scr, lane); continue; } r -= 128;
        if (r < 128) { const int kb = r >> 5, nb = r & 31; transpose_item(p.w_pb + (size_t)l * 256 * 1024, 1024, (bf16_t*)(ws + WS_WBRT + wl(l)), 1024, 64 * kb, 32 * nb, 32 * nb, 256 + 64 * kb, scr, lane); continue; } r -= 128;
        if (r < 256) { const int kb = r >> 5, nb = r & 31; transpose_item(p.w_pc + (size_t)l * 512 * 1024, 1024, (bf16_t*)(ws + WS_WBRT + wl(l)), 1024, 64 * kb, 32 * nb, 32 * nb, 512 + 64 * kb, scr, lane); continue; } r -= 256;
        { const int kb = r >> 5, nb = r & 31; transpose_item(p.w_out + (size_t)l * 1024 * 1024, 1024, (bf16_t*)(ws + WS_WOUTT + wl(l)), 1024, 64 * kb, 32 * nb, 32 * nb, 64 * kb, scr, lane); }
    }
}

constexpr int FK_STRIDE = 144, FV_STRIDE = 136, FV_OFF = 64 * FK_STRIDE, FBUF = 64 * FK_STRIDE + 64 * FV_STRIDE;
struct TileSrc { const bf16_t* k; int kld; const bf16_t* vt; int vld; };

DI void flash_load(const TileSrc& s, u32x4& kr, u32x4& vr, int tid) {
    const int row = tid >> 3, ch = tid & 7;
    kr = *(const u32x4*)(s.k + (size_t)row * s.kld + ch * 8);
    vr = *(const u32x4*)(s.vt + (size_t)row * s.vld + ch * 8);
}
DI void flash_store(LAS unsigned char* buf, const u32x4& kr, const u32x4& vr, int tid) {
    const int row = tid >> 3, ch = tid & 7;
    *(LAS u32x4*)(buf + row * FK_STRIDE + ch * 16) = kr;
    LAS u32x2* vp = (LAS u32x2*)(buf + FV_OFF + row * FV_STRIDE + ch * 16);
    vp[0] = (u32x2){vr.x, vr.y}; vp[1] = (u32x2){vr.z, vr.w};
}
DI void flash_qk(const LAS unsigned char* buf, const bf16x8 (&qf)[4], f32x16& s0, f32x16& s1, int r32, int hh) {
#pragma unroll
    for (int kk = 0; kk < 4; ++kk) {
        const bf16x8 a0 = *(const LAS bf16x8*)(buf + r32 * FK_STRIDE + (16 * kk + 8 * hh) * 2);
        const bf16x8 a1 = *(const LAS bf16x8*)(buf + (32 + r32) * FK_STRIDE + (16 * kk + 8 * hh) * 2);
        s0 = MFMA32(a0, qf[kk], s0); s1 = MFMA32(a1, qf[kk], s1);
    }
}
DI bf16x8 pack8(float a0, float a1, float a2, float a3, float a4, float a5, float a6, float a7) {
    u32x4 w; w.x = pk2(a0, a1); w.y = pk2(a2, a3); w.z = pk2(a4, a5); w.w = pk2(a6, a7); return __builtin_bit_cast(bf16x8, w);
}
DI void flash_pv_step(const LAS unsigned char* buf, int s, const bf16x8& pf, f32x16& o0, f32x16& o1, int r32, int hh) {
#pragma unroll
    for (int db = 0; db < 2; ++db) {
        const LAS unsigned char* vp = buf + FV_OFF + (32 * db + r32) * FV_STRIDE + (16 * s + 4 * hh) * 2;
        const u32x2 lo = *(const LAS u32x2*)vp, hi = *(const LAS u32x2*)(vp + 16);
        const bf16x8 va = __builtin_bit_cast(bf16x8, ((u32x4){lo.x, lo.y, hi.x, hi.y}));
        if (db == 0) o0 = MFMA32(va, pf, o0); else o1 = MFMA32(va, pf, o1);
    }
}
DI void flash_pv(const LAS unsigned char* buf, const f32x16& p0, const f32x16& p1, f32x16& o0, f32x16& o1, int r32, int hh) {
    flash_pv_step(buf, 0, pack8(p0[0], p0[1], p0[2], p0[3], p0[4], p0[5], p0[6], p0[7]), o0, o1, r32, hh);
    flash_pv_step(buf, 1, pack8(p0[8], p0[9], p0[10], p0[11], p0[12], p0[13], p0[14], p0[15]), o0, o1, r32, hh);
    flash_pv_step(buf, 2, pack8(p1[0], p1[1], p1[2], p1[3], p1[4], p1[5], p1[6], p1[7]), o0, o1, r32, hh);
    flash_pv_step(buf, 3, pack8(p1[8], p1[9], p1[10], p1[11], p1[12], p1[13], p1[14], p1[15]), o0, o1, r32, hh);
}

template <bool LAT>
DI void attn_unit(const Params& p, LAS unsigned char* lds, int layer, int b, int kvh, int qb) {
    constexpr int T = LAT ? 2048 : 256;
    int tid_l = threadIdx.x; asm volatile("" : "+v"(tid_l));
    const int tid = tid_l, w = __builtin_amdgcn_readfirstlane(tid >> 6), l = tid & 63, r32 = l & 31, hh = l >> 5;
    const unsigned char* ws = p.ws;
    const int tokbase = LAT ? NCTX + b * 2048 : b * 256;
    const int head = kvh * 4 + (w >> 1);
    const int myq = qb * 64 + (w & 1) * 32 + r32;
    bf16x8 qf[4];
    { const bf16_t* qp = (const bf16_t*)(ws + WS_AQ) + (size_t)(tokbase + myq) * 512 + head * 64 + 8 * hh;
#pragma unroll
      for (int kk = 0; kk < 4; ++kk) qf[kk] = *(const bf16x8*)(qp + 16 * kk); }
    float mrun = p.attn_sink[layer * 8 + head] * LOG2E;
    float lsum = hh == 0 ? 1.f : 0.f;
    f32x16 o0, o1;
#pragma unroll
    for (int i = 0; i < 16; ++i) { o0[i] = 0.f; o1[i] = 0.f; }
    int jlo = 0, nloc = 4;
    if (LAT) { jlo = qb < 2 ? 2 - qb : 0; int jhi = 33 - qb; if (jhi > 4) jhi = 4; nloc = jhi - jlo + 1; }
    const int ntile = LAT ? nloc + 8 : nloc;
    const bf16_t* AK = (const bf16_t*)(ws + WS_AK); const bf16_t* AVT = (const bf16_t*)(ws + WS_AVT) + (LAT ? (size_t)1024 * 1024 : 0);
    const bf16_t* CK = (const bf16_t*)(ws + WS_CKB) + (size_t)((layer * 4 + b) * 2 + kvh) * 512 * 64;
    const bf16_t* CV = (const bf16_t*)(ws + WS_CVT) + (size_t)((layer * 4 + b) * 2 + kvh) * 64 * 512;
    auto src_of = [&](int i, int& key0, bool& local) -> TileSrc {
        TileSrc s;
        if (i < nloc) { key0 = LAT ? qb * 64 - 128 + 64 * (jlo + i) : 64 * i; local = true;
            s.k = AK + (size_t)(tokbase + key0) * 128 + kvh * 64; s.kld = 128; s.vt = AVT + (size_t)((b * 2 + kvh) * 64) * T + key0; s.vld = T; }
        else { key0 = 64 * (i - nloc); local = false; s.k = CK + (size_t)key0 * 64; s.kld = 64; s.vt = CV + key0; s.vld = 512; }
        return s;
    };
    u32x4 kr, vr; int key0; bool local;
    { const TileSrc s = src_of(0, key0, local); flash_load(s, kr, vr, tid); flash_store(lds, kr, vr, tid); }
    for (int i = 0; i < ntile; ++i) {
        __syncthreads();
        const LAS unsigned char* buf = lds + (i & 1) * FBUF;
        int k0n; bool locn;
        if (i + 1 < ntile) { const TileSrc s = src_of(i + 1, k0n, locn); flash_load(s, kr, vr, tid); }
        { int kd; bool ld_; (void)src_of(i, kd, ld_); key0 = kd; local = ld_; }
        f32x16 s0, s1;
        { const float nm = -mrun;
#pragma unroll
          for (int r = 0; r < 16; ++r) { s0[r] = nm; s1[r] = nm; } }
        flash_qk(buf, qf, s0, s1, r32, hh);
        if (LAT && local && (jlo + i == 0 || jlo + i == 4)) {
#pragma unroll
            for (int r = 0; r < 16; ++r) { const int kp = key0 + crow(r, hh); int d0 = myq - kp; d0 = d0 < 0 ? -d0 : d0; int d1 = myq - kp - 32; d1 = d1 < 0 ? -d1 : d1;
                if (d0 > 128) s0[r] = -INFINITY; if (d1 > 128) s1[r] = -INFINITY; }
        }
        float mx = fmaxf(s0[0], s1[0]);
#pragma unroll
        for (int r = 1; r < 16; ++r) mx = fmaxf(fmaxf(mx, s0[r]), s1[r]);
        mx = fmaxf(mx, __shfl_xor(mx, 32));
        if (__builtin_amdgcn_ballot_w64(mx > 8.f) != 0ull) {
            const float inc = fmaxf(mx, 0.f), alpha = __builtin_amdgcn_exp2f(-inc);
            mrun += inc; lsum *= alpha; o0 = o0 * alpha; o1 = o1 * alpha;
            s0 = s0 - inc; s1 = s1 - inc;
        }
        float rs = 0.f;
#pragma unroll
        for (int r = 0; r < 16; ++r) { s0[r] = __builtin_amdgcn_exp2f(s0[r]); s1[r] = __builtin_amdgcn_exp2f(s1[r]); rs += s0[r] + s1[r]; }
        lsum += rs;
        flash_pv(buf, s0, s1, o0, o1, r32, hh);
        if (i + 1 < ntile) flash_store(lds + ((i + 1) & 1) * FBUF, kr, vr, tid);
    }
    const float ltot = lsum + __shfl_xor(lsum, 32), inv = 1.f / ltot;
    const bf16_t* AZ = (const bf16_t*)(ws + WS_AZ) + (size_t)(tokbase + myq) * 512 + head * 64;
    bf16_t* Y = (bf16_t*)(p.ws + WS_H) + (size_t)(tokbase + myq) * 1024 + 512 + head * 64;
#pragma unroll
    for (int db = 0; db < 2; ++db)
#pragma unroll
        for (int g4 = 0; g4 < 4; ++g4) {
            const int d = 32 * db + 8 * g4 + 4 * hh;
            const u32x2 z = *(const u32x2*)(AZ + d);
            const f32x16& o = db == 0 ? o0 : o1;
            u32x2 wv; wv.x = pk2(o[4 * g4] * inv * bflo(z.x), o[4 * g4 + 1] * inv * bfhi(z.x)); wv.y = pk2(o[4 * g4 + 2] * inv * bflo(z.y), o[4 * g4 + 3] * inv * bfhi(z.y));
            *(u32x2*)(Y + d) = wv;
        }
}

template <bool LAT>
DI void ret_unit(const Params& p, LAS unsigned char* lds, int layer, int b, int h, int qb, unsigned* flag) {
    constexpr int T = LAT ? 2048 : 256;
    int tid_l = threadIdx.x; asm volatile("" : "+v"(tid_l));
    const int tid = tid_l, w = __builtin_amdgcn_readfirstlane(tid >> 6), l = tid & 63, r32 = l & 31, hh = l >> 5;
    const unsigned char* ws = p.ws; asm volatile("" : "+s"(ws));
    const int tokbase = LAT ? NCTX + b * 2048 : b * 256;
    const int myq = qb * 256 + w * 32 + r32;
    const float* lg2 = (const float*)(ws + WS_LG2);
    const float lf = lg2[layer * 8 + h], lb = lg2[layer * 8 + 4 + h];
    bf16x8 qf[4];
    { const bf16_t* qp = (const bf16_t*)(ws + WS_RQ) + (size_t)(tokbase + myq) * 256 + h * 64 + 8 * hh;
#pragma unroll
      for (int kk = 0; kk < 4; ++kk) qf[kk] = *(const bf16x8*)(qp + 16 * kk); }
    f32x16 o0, o1;
#pragma unroll
    for (int i = 0; i < 16; ++i) { o0[i] = 0.f; o1[i] = 0.f; }
    f32x16 cf, cbk;
#pragma unroll
    for (int r = 0; r < 16; ++r) { cf[r] = __builtin_amdgcn_exp2f(-(float)crow(r, hh) * lf); cbk[r] = __builtin_amdgcn_exp2f((float)crow(r, hh) * lb); }
    const float g32f = __builtin_amdgcn_exp2f(-32.f * lf), g32b = __builtin_amdgcn_exp2f(32.f * lb);
    constexpr int nreal = 4;
    const int ntile = LAT ? nreal + 2 : nreal;
    if (LAT) {
        if (tid == 0) { unsigned sp = 0; while (__hip_atomic_load(flag, __ATOMIC_RELAXED, __HIP_MEMORY_SCOPE_AGENT) < 2u) { __builtin_amdgcn_s_sleep(4); if (++sp > (1u << 22)) break; }
            __builtin_amdgcn_fence(__ATOMIC_ACQUIRE, "agent"); asm volatile("s_waitcnt vmcnt(0)" ::: "memory"); }
        __syncthreads();
    }
    const bf16_t* RK = (const bf16_t*)(ws + WS_RK) + (size_t)tokbase * 256 + h * 64;
    const bf16_t* RVT = (const bf16_t*)(ws + WS_RVT) + (LAT ? (size_t)2 * 1024 * 1024 : 0) + (size_t)((b * 4 + h) * 64) * T;
    const bf16_t* ID = (const bf16_t*)(ws + WS_IDENT);
    const bf16_t* S0 = (const bf16_t*)(ws + WS_SCH) + (size_t)((((b * 4 + h) * 8 + qb) * 2)) * 4096;
    auto src_of = [&](int i) -> TileSrc {
        TileSrc s;
        if (i < nreal) { s.k = RK + (size_t)(qb * 256 + 64 * i) * 256; s.kld = 256; s.vt = RVT + qb * 256 + 64 * i; s.vld = T; }
        else { s.k = ID; s.kld = 64; s.vt = S0 + (size_t)(i - nreal) * 4096; s.vld = 64; }
        return s;
    };
    u32x4 kr, vr;
    { const TileSrc s = src_of(0); flash_load(s, kr, vr, tid); flash_store(lds, kr, vr, tid); }
    for (int i = 0; i < ntile; ++i) {
        __syncthreads();
        const LAS unsigned char* buf = lds + (i & 1) * FBUF;
        if (i + 1 < ntile) { const TileSrc s = src_of(i + 1); flash_load(s, kr, vr, tid); }
        f32x16 s0, s1;
#pragma unroll
        for (int r = 0; r < 16; ++r) { s0[r] = 0.f; s1[r] = 0.f; }
        flash_qk(buf, qf, s0, s1, r32, hh);
        if (i < nreal) {
            const int key0 = qb * 256 + 64 * i, qw = qb * 256 + w * 32;
            if (key0 + 63 < qw) {
                const float E = __builtin_amdgcn_exp2f((float)(myq - key0) * lf);
                s0 = s0 * cf * E; s1 = s1 * cf * (E * g32f);
            } else if (key0 > qw + 31) {
                const float E = __builtin_amdgcn_exp2f((float)(key0 - myq) * lb);
                s0 = s0 * cbk * E; s1 = s1 * cbk * (E * g32b);
            } else {
                const int dq = myq - key0;
                const float Ef = __builtin_amdgcn_exp2f((float)dq * lf), Eb = __builtin_amdgcn_exp2f(-(float)dq * lb);
                const f32x16 vf0 = cf * Ef, vb0 = cbk * Eb, vf1 = cf * (Ef * g32f), vb1 = cbk * (Eb * g32b);
#pragma unroll
                for (int r = 0; r < 16; ++r) {
                    const int d0 = dq - crow(r, hh), d1 = d0 - 32;
                    const float f0 = d0 > 0 ? vf0[r] : (d0 < 0 ? vb0[r] : 2.f);
                    const float f1 = d1 > 0 ? vf1[r] : (d1 < 0 ? vb1[r] : 2.f);
                    s0[r] *= f0; s1[r] *= f1;
                }
            }
        } else {
            const int pl = w * 32 + r32;
            const float f = (i == nreal) ? __builtin_amdgcn_exp2f((float)(pl + 1) * lf) : __builtin_amdgcn_exp2f((float)(256 - pl) * lb);
#pragma unroll
            for (int r = 0; r < 16; ++r) { s0[r] *= f; s1[r] *= f; }
        }
        flash_pv(buf, s0, s1, o0, o1, r32, hh);
        if (i + 1 < ntile) flash_store(lds + ((i + 1) & 1) * FBUF, kr, vr, tid);
    }
    float ss = 0.f;
#pragma unroll
    for (int r = 0; r < 16; ++r) ss += o0[r] * o0[r] + o1[r] * o1[r];
    ss += __shfl_xor(ss, 32);
    const float rstd = 1.f / sqrtf(ss * (1.f / 64.f) + EPS);
    const float* gn = p.ret_gn + (size_t)layer * 256 + h * 64;
    const bf16_t* RZ = (const bf16_t*)(ws + WS_RZ) + (size_t)(tokbase + myq) * 256 + h * 64;
    bf16_t* Y = (bf16_t*)(p.ws + WS_H) + (size_t)(tokbase + myq) * 1024 + 256 + h * 64;
#pragma unroll
    for (int db = 0; db < 2; ++db)
#pragma unroll
        for (int g4 = 0; g4 < 4; ++g4) {
            const int e = 32 * db + 8 * g4 + 4 * hh;
            const u32x2 z = *(const u32x2*)(RZ + e);
            const f32x4 g = *(const f32x4*)(gn + e);
            const f32x16& o = db == 0 ? o0 : o1;
            u32x2 wv; wv.x = pk2(o[4 * g4] * rstd * g[0] * bflo(z.x), o[4 * g4 + 1] * rstd * g[1] * bfhi(z.x));
            wv.y = pk2(o[4 * g4 + 2] * rstd * g[2] * bflo(z.y), o[4 * g4 + 3] * rstd * g[3] * bfhi(z.y));
            *(u32x2*)(Y + e) = wv;
        }
    if (!LAT) {
        const int dir = w >> 2, dblk = (w >> 1) & 1, eblk = w & 1;
        const bf16_t* A = (const bf16_t*)(ws + (dir ? WS_RKTB : WS_RKTF)) + (size_t)((b * 4 + h) * 64 + 32 * dblk + r32) * 256 + 8 * hh;
        const bf16_t* B = (const bf16_t*)(ws + WS_RVT) + (size_t)((b * 4 + h) * 64 + 32 * eblk + r32) * 256 + 8 * hh;
        f32x16 acc;
#pragma unroll
        for (int r = 0; r < 16; ++r) acc[r] = 0.f;
#pragma unroll 4
        for (int s = 0; s < 16; ++s) { const bf16x8 a = *(const bf16x8*)(A + 16 * s), bb = *(const bf16x8*)(B + 16 * s); acc = MFMA32(a, bb, acc); }
        float* o = p.out + O_ST + (size_t)((((b * 2 + layer) * 2 + dir) * 4 + h)) * 4096;
#pragma unroll
        for (int r = 0; r < 16; ++r) o[(32 * dblk + crow(r, hh)) * 64 + 32 * eblk + r32] = acc[r];
    }
}

DI void ret_state_job(const Params& p, LAS unsigned char* lds, int layer, int b, int h, int dir, unsigned* flag) {
    int tid_l = threadIdx.x; asm volatile("" : "+v"(tid_l));
    const int tid = tid_l, w = __builtin_amdgcn_readfirstlane(tid >> 6), l = tid & 63, r32 = l & 31, hh = l >> 5;
    const unsigned char* ws = p.ws; asm volatile("" : "+s"(ws));
    const int dblk = (w >> 1) & 1, eblk = w & 1;
    const float g256 = __builtin_amdgcn_exp2f(256.f * ((const float*)(ws + WS_LG2))[layer * 8 + dir * 4 + h]);
    f32x16 S;
    { const float* s0 = p.state_ret + ((size_t)((((b * 2 + layer) * 2 + dir) * 4 + h)) * 64) * 64;
#pragma unroll
      for (int r = 0; r < 16; ++r) S[r] = s0[(32 * dblk + crow(r, hh)) * 64 + 32 * eblk + r32]; }
    const bf16_t* Ag = (const bf16_t*)(ws + (dir ? WS_RKTBL : WS_RKTFL)) + (size_t)((b * 4 + h) * 64) * 2048;
    const bf16_t* Bg = (const bf16_t*)(ws + WS_RVT) + (size_t)2 * 1024 * 1024 + (size_t)((b * 4 + h) * 64) * 2048;
    bf16_t* SCH = (bf16_t*)(p.ws + WS_SCH) + (size_t)((b * 4 + h) * 8) * 2 * 4096;
    constexpr int RST = 528;
#pragma unroll 1
    for (int it = 0; it < 8; ++it) {
        const int c = dir ? 7 - it : it;
        __syncthreads();
#pragma unroll
        for (int q = 0; q < 8; ++q) {
            const int idx = tid + 512 * q, img = idx >> 11, rem = idx & 2047, row = rem >> 5, pc = rem & 31;
            const u32x4 v = *(const u32x4*)((img ? Bg : Ag) + (size_t)row * 2048 + c * 256 + pc * 8);
            *(LAS u32x4*)(lds + img * 64 * RST + row * RST + pc * 16) = v;
        }
        __syncthreads();
        if (w < 4) {
            { bf16_t* o = SCH + (size_t)(c * 2 + dir) * 4096 + (size_t)(32 * eblk + r32) * 64 + 32 * dblk + 4 * hh;
#pragma unroll
              for (int g4 = 0; g4 < 4; ++g4) { u32x2 wv; wv.x = pk2(S[4 * g4], S[4 * g4 + 1]); wv.y = pk2(S[4 * g4 + 2], S[4 * g4 + 3]); *(u32x2*)(o + 8 * g4) = wv; } }
            f32x16 acc;
#pragma unroll
            for (int r = 0; r < 16; ++r) acc[r] = 0.f;
            const LAS unsigned char* ap = lds + (32 * dblk + r32) * RST + 16 * hh;
            const LAS unsigned char* bp = lds + 64 * RST + (32 * eblk + r32) * RST + 16 * hh;
#pragma unroll
            for (int s = 0; s < 16; ++s) { const bf16x8 a = *(const LAS bf16x8*)(ap + 32 * s), bb = *(const LAS bf16x8*)(bp + 32 * s); acc = MFMA32(a, bb, acc); }
            S = S * g256 + acc;
        }
    }
    asm volatile("s_waitcnt vmcnt(0)" ::: "memory");
    __syncthreads();
    if (tid == 0) { __builtin_amdgcn_fence(__ATOMIC_RELEASE, "agent"); asm volatile("s_waitcnt vmcnt(0)" ::: "memory");
        __hip_atomic_fetch_add(flag, 1u, __ATOMIC_RELAXED, __HIP_MEMORY_SCOPE_AGENT); }
}

DI void dft_nyquist_job(const Params& p, int b) {
    int tid_l = threadIdx.x; asm volatile("" : "+v"(tid_l));
    const int tid = tid_l, w = __builtin_amdgcn_readfirstlane(tid >> 6), l = tid & 63;
    const bf16_t* U = (const bf16_t*)(p.ws + WS_UTL) + (size_t)(b * 256) * 1024;
    const size_t tok = (size_t)NCTX + (size_t)b * 2048 + 1024;
    const bf16_t* FZ = (const bf16_t*)(p.ws + WS_FZ) + tok * 256; bf16_t* Y = (bf16_t*)(p.ws + WS_H) + tok * 1024;
#pragma unroll 1
    for (int c = 0; c < 32; ++c) {
        const int ch = w * 32 + c; float s = 0.f;
#pragma unroll
        for (int q = 0; q < 4; ++q) { const u32x4 v = *(const u32x4*)(U + (size_t)((q >> 1) * 1024 + ch) * 1024 + (q & 1) * 512 + l * 8);
            s += (bflo(v.x) - bfhi(v.x)) + (bflo(v.y) - bfhi(v.y)) + (bflo(v.z) - bfhi(v.z)) + (bflo(v.w) - bfhi(v.w)); }
        s = wave_sum(s);
        if (l == 0) Y[ch] = f2bf(s * 0.02209708691207961f * bflo((unsigned)FZ[ch]));
    }
}

DI void mixer_phase(const Params& p, LAS unsigned char* lds, int slot) {
    const int layer = slot & 1;
    unsigned* ctr = (unsigned*)(p.ws + WS_CTL) + 64 * slot;
    volatile LAS int* bc = (volatile LAS int*)(lds + LDS_RING);
    const int tid = threadIdx.x;
    for (;;) {
        __syncthreads();
        if (tid == 0) bc[0] = (int)atomicAdd(ctr, 1u);
        __syncthreads();
        const int u = bc[0];
        if (u >= 900) break;
        unsigned* sflag = (unsigned*)(p.ws + WS_CTL) + 768 + 16 * slot;
        if (u < 32) { ret_state_job(p, lds, layer, u >> 3, (u >> 1) & 3, u & 1, sflag + (u >> 1)); }
        else if (u < 96) {
            const int v = u - 32, part = v & 3, tile = v >> 2;
            pg8::Gemm g; OneUnit S; EpiDftHalf E;
            g.A = (const bf16_t*)(p.ws + WS_TABL) + (size_t)part * 1024 * 1024; g.Bt = (const bf16_t*)(p.ws + WS_UTL) + (size_t)part * 1024 * 1024; g.M = 1024; g.N = 1024; g.K = 1024;
            S.u.pm = tile & 3; S.u.pn = tile >> 2;
            E.FZ = (const bf16_t*)(p.ws + WS_FZ); E.Y = (bf16_t*)(p.ws + WS_H); E.PART = (bf16_t*)(p.ws + WS_PART); E.cnt = (unsigned*)(p.ws + WS_CTL) + 256 + 32 * slot; E.half = part;
            pg8::gemm_phase<EpiDftHalf, OneUnit, false, true>(lds, g, S, E);
        } else if (u < 100) { dft_nyquist_job(p, u - 96); }
        else if (u >= 484 && u < 516) {
            const int i = u - 484;
            pg8::Gemm g; OneUnit S; EpiDft E;
            E.FZ = (const bf16_t*)(p.ws + WS_FZ); E.Y = (bf16_t*)(p.ws + WS_H);
            g.A = (const bf16_t*)(p.ws + WS_TABC); g.Bt = (const bf16_t*)(p.ws + WS_UTC); g.M = 256; g.N = 8192; g.K = 512; S.u.pm = 0; S.u.pn = i; E.tokbase = 0; E.T = 256;
            pg8::gemm_phase<EpiDft, OneUnit, false, true>(lds, g, S, E);
        } else if (u < 356) { const int i = u - 100; attn_unit<true>(p, lds, layer, i >> 6, (i >> 5) & 1, i & 31); }
        else if (u < 484) { const int i = u - 356; ret_unit<false>(p, lds, layer, i >> 2, i & 3, 0, nullptr); }
        else if (u < 772) { const int i = u - 516; attn_unit<false>(p, lds, layer, i >> 3, (i >> 2) & 1, i & 3); }
        else { const int i = u - 772; ret_unit<true>(p, lds, layer, i >> 5, (i >> 3) & 3, i & 7, sflag + (i >> 3)); }
    }
}

#define RLX_AGENT __ATOMIC_RELAXED, __HIP_MEMORY_SCOPE_AGENT
#define XB_TMO      128
#define XB_XCNT(j)  (256  + 64 * (j))
#define XB_XSUB(j)  (1280 + 64 * (j))
#define XB_XGEN(j)  (2304 + 64 * (j))
#define XB_TOP      3328
#define XB_TOPGEN   3392
#define XCD_BAR_WORDS 3456
#define XB_SPIN_CAP (1u << 18)

__device__ __forceinline__ unsigned xb_ld(unsigned* p)              { return __hip_atomic_load(p, __ATOMIC_RELAXED, __HIP_MEMORY_SCOPE_AGENT); }
__device__ __forceinline__ unsigned xb_add(unsigned* p, unsigned v) { return __hip_atomic_fetch_add(p, v, __ATOMIC_RELAXED, __HIP_MEMORY_SCOPE_AGENT); }
__device__ __forceinline__ unsigned xb_xcc_id() { return (unsigned)__builtin_amdgcn_s_getreg((3 << 11) | 20) & 0xFu; }
#define XB_SPIN(cond, bar) do { unsigned _sp = 0; while (cond) { __builtin_amdgcn_s_sleep(1); \
    if ((++_sp & 255u) == 0u) { if (xb_ld(&(bar)[XB_TMO])) break; if (_sp > XB_SPIN_CAP) { atomicAdd(&(bar)[XB_TMO], 1u); break; } } } } while (0)

struct XcdBarrier {
    unsigned* bar; unsigned x;
    volatile LAS unsigned* st;
};

__device__ __forceinline__ XcdBarrier xcd_barrier_post(unsigned* bar, volatile LAS unsigned* st) {
    XcdBarrier b; b.bar = bar; b.x = xb_xcc_id(); b.st = st;
    if (threadIdx.x == 0) (void)xb_add(&bar[XB_XCNT(b.x)], 1u);
    return b;
}
__device__ __forceinline__ void xcd_barrier_complete(unsigned* bar, unsigned x, unsigned& nloc, unsigned& nx) {
    const unsigned G = gridDim.x * gridDim.y * gridDim.z;
    unsigned sum, cnt, mine, sp = 0u;
    for (;;) {
        sum = 0u; cnt = 0u; mine = 0u;
#pragma unroll
        for (unsigned j = 0; j < 16; ++j) { const unsigned c = xb_ld(&bar[XB_XCNT(j)]); sum += c; cnt += (c > 0u) ? 1u : 0u; mine = (j == x) ? c : mine; }
        if (sum == G) break;
        __builtin_amdgcn_s_sleep(1);
        if ((++sp & 255u) == 0u) { if (xb_ld(&bar[XB_TMO])) break; if (sp > XB_SPIN_CAP) { atomicAdd(&bar[XB_TMO], 1u); break; } }
    }
    nloc = mine > 0u ? mine : 1u; nx = cnt > 0u ? cnt : 1u;
}

__device__ __forceinline__ void xcd_barrier(const XcdBarrier& b) {
    asm volatile("s_waitcnt vmcnt(0)" ::: "memory");
    __syncthreads();
    if (threadIdx.x == 0) {
        unsigned* bar = b.bar;
        __builtin_amdgcn_s_waitcnt(0);
        unsigned nloc = b.st[0], nx = b.st[1];
        if (nloc == 0u) { xcd_barrier_complete(bar, b.x, nloc, nx); b.st[0] = nloc; b.st[1] = nx; }
        const unsigned old = xb_add(&bar[XB_XSUB(b.x)], 1u);
        const unsigned gen = old / nloc;
        if (old + 1u == (gen + 1u) * nloc) {
            __builtin_amdgcn_fence(__ATOMIC_RELEASE, "agent");
            asm volatile("s_waitcnt vmcnt(0)" ::: "memory");
            const unsigned og = xb_add(&bar[XB_TOP], 1u);
            const unsigned tg = og / nx;
            if (og + 1u == (tg + 1u) * nx) xb_add(&bar[XB_TOPGEN], 1u);
            else XB_SPIN(xb_ld(&bar[XB_TOPGEN]) == tg, bar);
            __builtin_amdgcn_fence(__ATOMIC_ACQUIRE, "agent");
            xb_add(&bar[XB_XGEN(b.x)], 1u);
            asm volatile("s_waitcnt vmcnt(0)" ::: "memory");
        } else {
            XB_SPIN(xb_ld(&bar[XB_XGEN(b.x)]) == gen, bar);
            __builtin_amdgcn_fence(__ATOMIC_ACQUIRE, "agent");
            asm volatile("s_waitcnt vmcnt(0)" ::: "memory");
        }
    }
    __syncthreads();
}

__global__ void __launch_bounds__(512, 2) fwd_kernel(Params p) {
    extern __shared__ __attribute__((aligned(16))) unsigned char lds_raw[];
    LAS unsigned char* lds = (LAS unsigned char*)lds_raw;
    cg::grid_group grid = cg::this_grid();
    const int lo = p.ph_lo, hi = p.ph_hi, G = gridDim.x;
#define IN(k) (lo <= (k) && (k) < hi)
#ifndef PHMASK
#define PHMASK 0x7f
#endif
#define PH_ON(k) ((PHMASK >> (k)) & 1)
#ifndef REPMASK
#define REPMASK 0
#endif
#define REP_ON(k) ((REPMASK >> (k)) & 1)
    { volatile LAS unsigned* z = (volatile LAS unsigned*)(lds + LDS_RING); if (threadIdx.x < 32) z[threadIdx.x] = 0u; }
    __syncthreads();
    XcdBarrier bar = xcd_barrier_post((unsigned*)(p.ws + WS_CTL) + 1024, (volatile LAS unsigned*)(lds + LDS_RING + 64));
    if (lo < 0) grid.sync();
#define SEAM(k) do { if (IN(k) && IN((k) + 1)) xcd_barrier(bar); } while (0)
#pragma unroll 1
    for (int rep = 0; rep < 1 + 2 * REP_ON(0); ++rep)
    if (PH_ON(0) && IN(0)) { phase0(p, lds); }
    SEAM(0);
#pragma unroll 1
    for (int l = 0; l < 2; ++l) {
        const int pb = 1 + 5 * l;
#pragma unroll 1
        for (int rep = 0; rep < 1 + REP_ON(1); ++rep)
        if (PH_ON(1) && IN(pb)) { if (l == 0) { weight_prep(p, lds, true, true); phase0b(p, lds); } row_pass(p, l); }
        SEAM(pb);
#pragma unroll 1
        for (int rep = 0; rep < 1 + REP_ON(2); ++rep)
        if (PH_ON(2) && IN(pb + 1)) {
            pg8::Gemm g{(const bf16_t*)(p.ws + WS_H), (const bf16_t*)(p.ws + WS_WINT + wl(l)), NTOK, NWIN, DM}; pg8::StaticOrder S; S.init(NTOK, NWIN, G, (int)blockIdx.x);
            EpiIn E{p.ws, p.out, (const float*)(p.ws + WS_LG2), l, lds + LDS_STAGE};
            pg8::gemm_phase<EpiIn, pg8::StaticOrder, true, true>(lds, g, S, E);
        }
        SEAM(pb + 1);
#pragma unroll 1
        for (int rep = 0; rep < 1 + REP_ON(3); ++rep)
        if (PH_ON(3) && IN(pb + 2)) mixer_phase(p, lds, l + 2 * rep);
        SEAM(pb + 2);
#pragma unroll 1
        for (int rep = 0; rep < 1 + REP_ON(4); ++rep)
        if (PH_ON(4) && IN(pb + 3)) {
            pg8::Gemm g{(const bf16_t*)(p.ws + WS_H), (const bf16_t*)(p.ws + WS_WBRT + wl(l)), NTOK, DM, DM}; pg8::StaticOrder S; S.init(NTOK, DM, G, (int)blockIdx.x);
            EpiMerge E{p.ws + WS_MG8, (bf16_t*)(p.ws + WS_MERGED)};
            pg8::gemm_phase<EpiMerge, pg8::StaticOrder, false, true>(lds, g, S, E);
        }
        SEAM(pb + 3);
#pragma unroll 1
        for (int rep = 0; rep < 1 + REP_ON(5); ++rep)
        if (PH_ON(5) && IN(pb + 4)) {
            pg8::Gemm g{(const bf16_t*)(p.ws + WS_MERGED), (const bf16_t*)(p.ws + WS_WOUTT + wl(l)), NTOK, DM, DM}; pg8::StaticOrder S; S.init(NTOK, DM, G, (int)blockIdx.x);
            EpiOut E{(bf16_t*)(p.ws + WS_OUT)};
            pg8::gemm_phase<EpiOut, pg8::StaticOrder, false, true>(lds, g, S, E);
        }
        SEAM(pb + 4);
#pragma unroll 1
        for (int rep = 0; rep < 5 * REP_ON(7); ++rep) xcd_barrier(bar);
    }
    if (PH_ON(6) && IN(11)) row_pass(p, 2);
#undef IN
#undef SEAM
}

extern "C" void kernel_launch(void* const* d_in, const int* in_sizes, int n_in, void* d_out, int out_size, void* d_ws, size_t ws_size, hipStream_t stream) {
    static int grid = 0;
    if (grid == 0) {
        int dev = 0, cus = 0, per_cu = 0;
        if (n_in != 20 || ws_size < WS_END) { fprintf(stderr, "kernel_launch: unexpected inputs (n_in %d, ws %zu)\n", n_in, ws_size); grid = -1; return; }
        hipGetDevice(&dev);
        hipDeviceGetAttribute(&cus, hipDeviceAttributeMultiprocessorCount, dev);
        if (hipFuncSetAttribute((const void*)fwd_kernel, hipFuncAttributeMaxDynamicSharedMemorySize, LDS_BYTES) != hipSuccess) { fprintf(stderr, "kernel_launch: hipFuncSetAttribute failed\n"); grid = -1; return; }
        if (hipOccupancyMaxActiveBlocksPerMultiprocessor(&per_cu, (const void*)fwd_kernel, 512, LDS_BYTES) != hipSuccess || per_cu < 1) { fprintf(stderr, "kernel_launch: occupancy query says %d\n", per_cu); per_cu = 1; }
        (void)hipGetLastError();
        grid = cus * per_cu;
    }
    if (grid < 0) return;
    hipMemsetAsync((char*)d_ws + WS_CTL, 0, CTL_BYTES, stream);
    Params p{};
    const float** f = (const float**)&p;
    for (int i = 0; i < 20; ++i) f[i] = (const float*)d_in[i];
    p.out = (float*)d_out; p.ws = (unsigned char*)d_ws; p.ph_lo = 0; p.ph_hi = 12;
    void* args[] = {&p};
    const hipError_t e = hipLaunchCooperativeKernel((const void*)fwd_kernel, dim3(grid), dim3(512), args, LDS_BYTES, stream);
    if (e != hipSuccess) fprintf(stderr, "kernel_launch: cooperative launch failed: %s (grid %d)\n", hipGetErrorString(e), grid);
}
```

```cpp
#include <hip/hip_runtime.h>
#include <hip/hip_cooperative_groups.h>
#include <cstdio>
#include <cstdint>
namespace cg = cooperative_groups;

namespace pg8 {
#define PG8_LAS __attribute__((address_space(3)))
typedef unsigned short bf16_t;
typedef short bf16x8 __attribute__((ext_vector_type(8)));
typedef float f32x4 __attribute__((ext_vector_type(4)));
typedef unsigned u32x4 __attribute__((ext_vector_type(4)));
constexpr int BM = 256, BK = 64, HALF = 128, HTB = HALF * BK * 2  , STAGE_BYTES = 8 * HTB, NXCD = 8, WGM = 8;

__host__ __device__ __forceinline__ int lds_byte(int r, int c) { const int st = (r >> 4) * 2 + (c >> 5), rr = r & 15, cc = c & 31, ob = rr * 64 + cc * 2; return st * 1024 + (ob ^ (((ob >> 9) & 1) << 5)); }
__host__ __device__ __forceinline__ void stage_rc(int b, int& R, int& C) { const int st = b / 1024, sb = b % 1024, swz = sb ^ (((sb >> 9) & 1) << 5); R = (st >> 1) * 16 + swz / 64; C = (st & 1) * 32 + (swz % 64) / 2; }
__host__ __device__ __forceinline__ int perm32(int rho) { const int n = rho >> 4, i = rho & 15; return 8 * (i >> 2) + 4 * n + (i & 3); }

struct Unit { int pm, pn; };
struct Gemm { const bf16_t* A; const bf16_t* Bt; int M, N, K; };

struct StaticOrder {
    int nM, nN, nwg, G, c;
    __host__ __device__ void init(int M, int N, int G_, int c_) { nM = M / BM; nN = N / BM; nwg = nM * nN; G = G_; c = c_; }
    __host__ __device__ bool next(int i, Unit& u) const {
        const long L = (long)i * G + c; if (L >= nwg) return false;
        int wgid = (int)L; { const int q = nwg / NXCD, r = nwg % NXCD, xcd = wgid % NXCD, off = wgid / NXCD; wgid = (xcd < r ? xcd * (q + 1) : r * (q + 1) + (xcd - r) * q) + off; }
        const int nig = WGM * nN, gid = wgid / nig, fm = gid * WGM, gsz = (nM - fm) < WGM ? (nM - fm) : WGM;
        u.pm = fm + ((wgid % nig) % gsz); u.pn = (wgid % nig) / gsz; return true;
    }
    __device__ __forceinline__ void a_ready(const Unit&) const {}
    __device__ __forceinline__ void done(const Unit&) const {}
};
__device__ __forceinline__ unsigned cvt_pk_bf16(float lo, float hi) { unsigned r; asm volatile("v_cvt_pk_bf16_f32 %0, %1, %2" : "=v"(r) : "v"(lo), "v"(hi)); return r; }
template <class Epi, class Sched, bool ALIGN_EPI = false, bool SP2 = false>
__device__ __forceinline__ void gemm_phase(PG8_LAS unsigned char* lds, const Gemm g, const Sched& S, const Epi& E) {
    int tid_l = threadIdx.x; asm volatile("" : "+v"(tid_l));
    const int tid = tid_l, wid = __builtin_amdgcn_readfirstlane(tid >> 6), lane = tid & 63, wr = wid >> 2, wc = wid & 3, fr = lane & 15, fq = lane >> 4;
    const int K = g.K, nt = K / BK;
    unsigned voffA[2], voffB[2];
#pragma unroll
    for (int i = 0; i < 2; ++i) { int R, C; stage_rc(tid * 16 + i * 8192, R, C); const int Rb = Epi::PERM ? ((R & ~31) + perm32(R & 31)) : R;
        voffA[i] = (unsigned)(R * K + C) * 2u; voffB[i] = (unsigned)(Rb * K + C) * 2u; }
    const size_t kstep = (size_t)(BK * 2);
    const size_t hstep = (size_t)HALF * K * 2;
    const size_t tstep = 2 * hstep;
    const unsigned ldsw = (unsigned)wid * 1024u;
    const int aoff = lds_byte(wr * 64 + fr, fq * 8), boff = lds_byte(wc * 32 + fr, fq * 8);
#define PG8_SA(b, h) (((b) * 2 + (h)) * HTB)
#define PG8_SB(b, h) ((4 + (b) * 2 + (h)) * HTB)
#define PG8_STAGE(bufoff, gbase, voff) do { _Pragma("unroll") for (int _i = 0; _i < 2; ++_i) \
        __builtin_amdgcn_global_load_lds((const unsigned*)((const char*)(gbase) + (voff)[_i]), (PG8_LAS unsigned*)(lds + (bufoff) + ldsw + _i * 8192), 16, 0, 0); } while (0)
#define PG8_LDA(dst, b, h) do { _Pragma("unroll") for (int m = 0; m < 4; ++m) _Pragma("unroll") for (int k = 0; k < 2; ++k) dst[m][k] = *(const PG8_LAS bf16x8*)(lds + PG8_SA(b, h) + aoff + m * 2048 + k * 1024); } while (0)
#define PG8_LDB(dst, b, h) do { _Pragma("unroll") for (int n = 0; n < 2; ++n) _Pragma("unroll") for (int k = 0; k < 2; ++k) dst[n][k] = *(const PG8_LAS bf16x8*)(lds + PG8_SB(b, h) + boff + n * 2048 + k * 1024); } while (0)
#define PG8_MMA(ai, bj, At, Bt) do { __builtin_amdgcn_s_setprio(1); _Pragma("unroll") for (int m = 0; m < 4; ++m) _Pragma("unroll") for (int n = 0; n < 2; ++n) _Pragma("unroll") for (int k = 0; k < 2; ++k) \
        acc[ai][bj][m][n] = __builtin_amdgcn_mfma_f32_16x16x32_bf16(Bt[n][k], At[m][k], acc[ai][bj][m][n], 0, 0, 0); __builtin_amdgcn_s_setprio(0); } while (0)
#define PG8_WAIT_V(n) asm volatile("s_waitcnt vmcnt(" #n ")" ::: "memory")
#define PG8_WAIT_L(n) asm volatile("s_waitcnt lgkmcnt(" #n ")" ::: "memory")
#define PG8_BAR __builtin_amdgcn_s_barrier()
#define PG8_SCHED __builtin_amdgcn_sched_barrier(0)
    Unit cur, nxt; int ui = 0;
    if (!S.next(0, cur)) return;
    f32x4 acc[2][2][4][2];
#pragma unroll
    for (int a = 0; a < 2; ++a)
#pragma unroll
        for (int b = 0; b < 2; ++b)
#pragma unroll
            for (int m = 0; m < 4; ++m)
#pragma unroll
                for (int n = 0; n < 2; ++n) acc[a][b][m][n] = (f32x4){0.f, 0.f, 0.f, 0.f};
    bf16x8 At[4][2], B0[2][2], B1[2][2];
    const char* cA = (const char*)g.A + (size_t)cur.pm * tstep; const char* cB = (const char*)g.Bt + (size_t)cur.pn * tstep;
    S.a_ready(cur);
    if constexpr (SP2) {
        PG8_STAGE(PG8_SB(0, 0), cB, voffB); PG8_STAGE(PG8_SB(0, 1), cB + hstep, voffB); PG8_STAGE(PG8_SA(0, 0), cA, voffA); PG8_STAGE(PG8_SA(0, 1), cA + hstep, voffA);
        if (wr == 1) PG8_BAR;
        PG8_WAIT_V(2); PG8_BAR;
        PG8_STAGE(PG8_SB(1, 0), cB + kstep, voffB); PG8_STAGE(PG8_SA(1, 0), cA + kstep, voffA); PG8_STAGE(PG8_SB(1, 1), cB + hstep + kstep, voffB);
        PG8_WAIT_V(6); PG8_BAR;
    } else {
        PG8_STAGE(PG8_SB(0, 0), cB, voffB); PG8_STAGE(PG8_SA(0, 0), cA, voffA); PG8_STAGE(PG8_SB(0, 1), cB + hstep, voffB); PG8_STAGE(PG8_SA(0, 1), cA + hstep, voffA);
        if (wr == 1) PG8_BAR;
        PG8_WAIT_V(4); PG8_BAR;
        PG8_STAGE(PG8_SB(1, 0), cB + kstep, voffB); PG8_STAGE(PG8_SA(1, 0), cA + kstep, voffA); PG8_STAGE(PG8_SB(1, 1), cB + hstep + kstep, voffB);
        PG8_WAIT_V(6); PG8_BAR;
    }
    for (;;) {
        const bool has_next = S.next(ui + 1, nxt);
        const char* nA = has_next ? (const char*)g.A + (size_t)nxt.pm * tstep : cA; const char* nB = has_next ? (const char*)g.Bt + (size_t)nxt.pn * tstep : cB;
        for (int t = 0; t < nt; t += 2) {
            if constexpr (Epi::HOOK) { if (t == 4 || t == 8) E.seg(acc, cur, t, wr, wc, fr, fq); }
            const bool last = (t == nt - 2);
            const char* a1 = cA + (size_t)(t + 1) * kstep;
            const char* a2 = last ? nA : cA + (size_t)(t + 2) * kstep; const char* b2 = last ? nB : cB + (size_t)(t + 2) * kstep;
            const char* a3 = a2 + kstep; const char* b3 = b2 + kstep;
            if (last && has_next) S.a_ready(nxt);
            if constexpr (SP2) {
            PG8_LDB(B0, 0, 0); PG8_LDB(B1, 0, 1); PG8_SCHED; PG8_LDA(At, 0, 0); PG8_STAGE(PG8_SA(1, 1), a1 + hstep, voffA);
            PG8_WAIT_V(8); PG8_WAIT_L(0); PG8_BAR; PG8_MMA(0, 0, At, B0); PG8_MMA(0, 1, At, B1); PG8_BAR; PG8_SCHED;
            PG8_LDA(At, 0, 1); PG8_STAGE(PG8_SB(0, 0), b2, voffB); PG8_STAGE(PG8_SB(0, 1), b2 + hstep, voffB); PG8_STAGE(PG8_SA(0, 0), a2, voffA);
            PG8_WAIT_V(8); PG8_WAIT_L(0); PG8_BAR; PG8_MMA(1, 0, At, B0); PG8_MMA(1, 1, At, B1); PG8_BAR; PG8_SCHED;
            PG8_LDB(B0, 1, 0); PG8_LDB(B1, 1, 1); PG8_SCHED; PG8_LDA(At, 1, 0); PG8_STAGE(PG8_SA(0, 1), a2 + hstep, voffA);
            PG8_WAIT_V(8); PG8_WAIT_L(0); PG8_BAR; PG8_MMA(0, 0, At, B0); PG8_MMA(0, 1, At, B1); PG8_BAR; PG8_SCHED;
            PG8_LDA(At, 1, 1); PG8_STAGE(PG8_SB(1, 0), b3, voffB); PG8_STAGE(PG8_SB(1, 1), b3 + hstep, voffB); PG8_STAGE(PG8_SA(1, 0), a3, voffA);
            PG8_WAIT_V(8); PG8_WAIT_L(0); PG8_BAR; PG8_MMA(1, 0, At, B0); PG8_MMA(1, 1, At, B1); PG8_BAR; PG8_SCHED;
            } else {
            PG8_LDB(B0, 0, 0); PG8_SCHED; PG8_LDA(At, 0, 0); PG8_STAGE(PG8_SA(1, 1), a1 + hstep, voffA);
            PG8_WAIT_L(8); PG8_BAR; PG8_WAIT_L(0); PG8_MMA(0, 0, At, B0); PG8_BAR; PG8_SCHED;
            PG8_LDB(B1, 0, 1); PG8_STAGE(PG8_SB(0, 0), b2, voffB);
            PG8_BAR; PG8_WAIT_L(0); PG8_MMA(0, 1, At, B1); PG8_BAR;
            PG8_LDA(At, 0, 1); PG8_STAGE(PG8_SA(0, 0), a2, voffA);
            PG8_BAR; PG8_WAIT_L(0); PG8_MMA(1, 0, At, B0); PG8_BAR; PG8_SCHED;
            PG8_STAGE(PG8_SB(0, 1), b2 + hstep, voffB);
            PG8_WAIT_V(6); PG8_BAR; PG8_MMA(1, 1, At, B1); PG8_BAR;
            PG8_LDB(B0, 1, 0); PG8_SCHED; PG8_LDA(At, 1, 0); PG8_STAGE(PG8_SA(0, 1), a2 + hstep, voffA);
            PG8_WAIT_L(8); PG8_BAR; PG8_WAIT_L(0); PG8_MMA(0, 0, At, B0); PG8_BAR; PG8_SCHED;
            PG8_LDB(B1, 1, 1); PG8_STAGE(PG8_SB(1, 0), b3, voffB);
            PG8_BAR; PG8_WAIT_L(0); PG8_MMA(0, 1, At, B1); PG8_BAR;
            PG8_LDA(At, 1, 1); PG8_STAGE(PG8_SA(1, 0), a3, voffA);
            PG8_BAR; PG8_WAIT_L(0); PG8_MMA(1, 0, At, B0); PG8_BAR; PG8_SCHED;
            PG8_STAGE(PG8_SB(1, 1), b3 + hstep, voffB);
            PG8_WAIT_V(6); PG8_BAR; PG8_MMA(1, 1, At, B1); PG8_BAR;
            }
        }
        if constexpr (ALIGN_EPI) { if (wr == 0) PG8_BAR; }
        if constexpr (!Epi::AFTER_DRAIN) { E(acc, cur, wr, wc, fr, fq); S.done(cur); }
        if (!has_next) break;
#pragma unroll
        for (int a = 0; a < 2; ++a)
#pragma unroll
            for (int b = 0; b < 2; ++b)
#pragma unroll
                for (int m = 0; m < 4; ++m)
#pragma unroll
                    for (int n = 0; n < 2; ++n) acc[a][b][m][n] = (f32x4){0.f, 0.f, 0.f, 0.f};
        cur = nxt; cA = nA; cB = nB; ++ui;
        if constexpr (ALIGN_EPI) { if (wr == 1) PG8_BAR; }
    }
    PG8_WAIT_V(0);
    if constexpr (!ALIGN_EPI) { if (wr == 0) PG8_BAR; }
    PG8_BAR;
    if constexpr (Epi::AFTER_DRAIN) { E.fused(acc, cur, wr, wc, fr, fq, lds, wid, lane); S.done(cur); }
#undef PG8_SA
#undef PG8_SB
#undef PG8_STAGE
#undef PG8_LDA
#undef PG8_LDB
#undef PG8_MMA
#undef PG8_WAIT_V
#undef PG8_WAIT_L
#undef PG8_BAR
#undef PG8_SCHED
}
}

#define DI __device__ __forceinline__
#define LAS __attribute__((address_space(3)))
using pg8::bf16_t; using pg8::bf16x8; using pg8::f32x4; using pg8::Unit;
typedef float f32x16 __attribute__((ext_vector_type(16)));
typedef unsigned u32x4 __attribute__((ext_vector_type(4)));
typedef unsigned u32x2 __attribute__((ext_vector_type(2)));
typedef float f32x2_t __attribute__((ext_vector_type(2)));
typedef __bf16 bf16x2_t __attribute__((ext_vector_type(2)));

constexpr int NTOK = 16384, NCTX = 8192, DM = 1024, NWIN = 6144, WIN_LD = 5888;
constexpr float LOG2E = 1.4426950408889634f;
constexpr float EPS = 1e-6f;
constexpr size_t MiB = 1u << 20;
constexpr size_t WS_CTL = 0, CTL_BYTES = 32768;
constexpr size_t WS_MOD = 1 * MiB;
constexpr size_t WS_LG2 = WS_MOD + 128 * 1024;
constexpr size_t WS_ROPE = WS_LG2 + 256;
constexpr size_t WS_IDENT = WS_ROPE + 8192;
constexpr size_t WS_W4 = 2 * MiB;
constexpr size_t WS_TABC = 3 * MiB;
constexpr size_t WS_CKB = 3 * MiB + 512 * 1024;
constexpr size_t WS_CVT = WS_CKB + 1 * MiB;
constexpr size_t WS_S0T = WS_CVT + 1 * MiB;
constexpr size_t WS_TABL = 6 * MiB;
constexpr size_t WS_WINT = 22 * MiB;
constexpr size_t WS_WBRT = 34 * MiB;
constexpr size_t WS_WOUTT = 36 * MiB;
constexpr size_t WS_H = 38 * MiB;
constexpr size_t WS_UTC = 70 * MiB, WS_UTL = 78 * MiB, WS_FZ = 86 * MiB, WS_RQ = 94 * MiB, WS_RK = 102 * MiB, WS_RVT = 110 * MiB, WS_RZ = 118 * MiB,
                 WS_AQ = 126 * MiB, WS_AK = 142 * MiB, WS_AVT = 146 * MiB, WS_AZ = 150 * MiB, WS_RKTF = 166 * MiB, WS_RKTB = 170 * MiB, WS_MG8 = 174 * MiB, WS_PART = 222 * MiB, WS_RKTFL = 230 * MiB, WS_RKTBL = 234 * MiB, WS_W2 = 238 * MiB, WS_SCH = 254 * MiB, WS_END = 256 * MiB;
constexpr size_t WS_MERGED = 70 * MiB;
constexpr size_t WS_OUT = 102 * MiB;
DI size_t wl(int l) { return l ? (WS_W2 - WS_WINT) : 0; }
constexpr size_t O_Y = 0, O_CK = 16777216, O_CV = 18874368, O_ST = 20971520;
constexpr int LDS_RING = 131072, LDS_STAGE = LDS_RING + 256, STAGE_WAVE = 2560, LDS_BYTES = LDS_STAGE + 8 * STAGE_WAVE;

struct Params {
    const float *x_prompt, *x_sample, *cache_k, *cache_v, *state_ret, *c, *c_ctx, *w_mod, *b_mod, *g_pre, *g_post, *w_in, *w_four, *ret_decay, *ret_gn, *attn_sink,
                *w_pa, *w_pb, *w_pc, *w_out;
    float* out; unsigned char* ws; int ph_lo, ph_hi;
};

DI unsigned pk2(float lo, float hi) { f32x2_t v = {lo, hi}; bf16x2_t b = __builtin_convertvector(v, bf16x2_t); return __builtin_bit_cast(unsigned, b); }
DI bf16_t f2bf(float x) { return (bf16_t)(pk2(x, 0.f) & 0xffffu); }
DI float bflo(unsigned u) { return __uint_as_float(u << 16); }
DI float bfhi(unsigned u) { return __uint_as_float(u & 0xffff0000u); }
DI float silu_f(float v) { return v * __builtin_amdgcn_rcpf(1.f + __expf(-v)); }
DI float sigm_f(float v) { return __builtin_amdgcn_rcpf(1.f + __expf(-v)); }
DI float wave_sum(float v) {
#pragma unroll
    for (int o = 1; o < 64; o <<= 1) v += __shfl_xor(v, o);
    return v;
}
#define LDS_WAIT() asm volatile("s_waitcnt lgkmcnt(0)" ::: "memory")
#define MFMA32(a, b, c) __builtin_amdgcn_mfma_f32_32x32x16_bf16((a), (b), (c), 0, 0, 0)
DI int crow(int reg, int h) { return (reg & 3) + 8 * (reg >> 2) + 4 * h; }

DI size_t fragmajor(int bh, int r, int t) { const size_t blk = (size_t)(bh * 2 + (r >> 5)) * 8 + (t >> 8); const size_t step = blk * 16 + ((t & 255) >> 4); const size_t lane = step * 64 + ((t >> 3) & 1) * 32 + (r & 31); return lane * 8 + (t & 7); }
DI int colperm(int blk) { return (blk >= 2 && blk <= 5) ? (blk ^ 6) : blk; }
struct EpiIn {
    static constexpr bool PERM = true, AFTER_DRAIN = false, HOOK = false;
    unsigned char* ws; float* out; const float* lg2; int layer; LAS unsigned char* stage;
    DI void rope8(float (&v)[8], int t, int wc, int fq) const {
        const float* rc = (const float*)(ws + WS_ROPE); const float* rs = rc + 1024;
        const int pos = (wc & 1) ? (t & 63) : (t >> 6);
        const int i0 = 8 * (fq & 1);
        const f32x4 c_lo = *(const f32x4*)(rc + pos * 16 + i0), c_hi = *(const f32x4*)(rc + pos * 16 + i0 + 4);
        const f32x4 s_lo = *(const f32x4*)(rs + pos * 16 + i0), s_hi = *(const f32x4*)(rs + pos * 16 + i0 + 4);
        const bool second = (fq >> 1) != 0;
#pragma unroll
        for (int e = 0; e < 8; ++e) {
            const float pv = __shfl_xor(v[e], 32);
            const float cs = e < 4 ? c_lo[e & 3] : c_hi[e & 3], sn = e < 4 ? s_lo[e & 3] : s_hi[e & 3];
            v[e] = v[e] * cs + (second ? pv : -pv) * sn;
        }
    }
    DI void tstore(const float (&va)[8], const float (&vb)[8], int fr, int fq, int wid, bf16_t* g, size_t chs) const {
        LAS unsigned char* st = stage + wid * STAGE_WAVE;
#pragma unroll
        for (int e = 0; e < 8; ++e) { *(LAS bf16_t*)(st + (8 * fq + e) * 80 + fr * 2) = f2bf(va[e]); *(LAS bf16_t*)(st + (8 * fq + e) * 80 + (16 + fr) * 2) = f2bf(vb[e]); }
        LDS_WAIT();
        const int lane = fq * 16 + fr;
#pragma unroll
        for (int k = 0; k < 2; ++k) { const int pc = lane + 64 * k, ch = pc >> 2, tp = pc & 3;
            const u32x4 w = *(const LAS u32x4*)(st + ch * 80 + tp * 16);
            *(u32x4*)(g + (size_t)ch * chs + tp * 8) = w; }
        LDS_WAIT();
    }
    template <int BJ, int TYPE, bool LATT>
    DI void tile(const f32x4 (&acc)[2][2][4][2], const Unit& u, int wr, int wc, int fr, int fq) const {
        constexpr int T = LATT ? 2048 : 256;
        const int cb = colperm(u.pn) * 256 + BJ * 128, c0 = cb + wc * 32 + 8 * fq;
        const float* rc = (const float*)(ws + WS_ROPE); const float* rs = rc + 1024;
        if (TYPE == 0 || TYPE == 4 || TYPE == 8 || TYPE == 3) {
            const int wid = wr * 4 + wc;
            const int bq = LATT ? (u.pm - 32) >> 3 : u.pm, tq = LATT ? ((u.pm - 32) & 7) * 256 : 0;
#pragma unroll
            for (int ai = 0; ai < 2; ++ai)
#pragma unroll
                for (int mp = 0; mp < 2; ++mp) {
                    int t0 = tq + ai * 128 + wr * 64 + mp * 32; asm volatile("" : "+s"(t0));
                    float va[8], vb[8];
#pragma unroll
                    for (int e = 0; e < 8; ++e) { va[e] = acc[ai][BJ][2 * mp][e >> 2][e & 3]; vb[e] = acc[ai][BJ][2 * mp + 1][e >> 2][e & 3]; }
                    if (TYPE == 0) {
                        const int seg = cb >= 256 ? 1 : 0, ch0 = cb - seg * 256 + wc * 32;
                        bf16_t* g = LATT ? (bf16_t*)(ws + WS_UTL) + ((size_t)((seg * 2 + (t0 >> 10)) * 1024 + bq * 256 + ch0) * 1024 + (t0 & 1023))
                                         : (bf16_t*)(ws + WS_UTC) + ((size_t)(bq * 256 + ch0) * 512 + seg * 256 + t0);
                        tstore(va, vb, fr, fq, wid, g, LATT ? 1024 : 512);
                    } else if (TYPE == 4) {
                        const int cc0 = cb - 1280 + wc * 32;
                        tstore(va, vb, fr, fq, wid, (bf16_t*)(ws + WS_RVT) + (LATT ? (size_t)2 * 1024 * 1024 : 0) + ((size_t)(bq * 256 + cc0) * T + t0), T);
                    } else if (TYPE == 8) {
                        const int cc0 = cb - 2432 + wc * 32;
                        tstore(va, vb, fr, fq, wid, (bf16_t*)(ws + WS_AVT) + (LATT ? (size_t)1024 * 1024 : 0) + ((size_t)(bq * 128 + cc0) * T + t0), T);
                    } else {
                        const int cc0 = cb - 1024 + wc * 32, hd = cc0 >> 6;
                        const float lf = lg2[layer * 8 + hd], lb = lg2[layer * 8 + 4 + hd];
                        if (LATT) {
                            rope8(va, t0 + fr, wc, fq); rope8(vb, t0 + 16 + fr, wc, fq);
                            bf16_t* d0 = (bf16_t*)(ws + WS_RK) + (size_t)(NCTX + bq * 2048 + t0 + fr) * 256 + cc0 + 8 * fq;
                            u32x4 w; w.x = pk2(va[0] * 0.125f, va[1] * 0.125f); w.y = pk2(va[2] * 0.125f, va[3] * 0.125f); w.z = pk2(va[4] * 0.125f, va[5] * 0.125f); w.w = pk2(va[6] * 0.125f, va[7] * 0.125f);
                            *(u32x4*)d0 = w;
                            w.x = pk2(vb[0] * 0.125f, vb[1] * 0.125f); w.y = pk2(vb[2] * 0.125f, vb[3] * 0.125f); w.z = pk2(vb[4] * 0.125f, vb[5] * 0.125f); w.w = pk2(vb[6] * 0.125f, vb[7] * 0.125f);
                            *(u32x4*)(d0 + 16 * 256) = w;
                        }
                        const float ta = (float)((t0 & 255) + fr), tb = ta + 16.f;
                        const float wfa = 0.125f * __builtin_amdgcn_exp2f((255.f - ta) * lf), wfb = 0.125f * __builtin_amdgcn_exp2f((255.f - tb) * lf);
                        const float ra = __builtin_amdgcn_exp2f(ta * lb - (255.f - ta) * lf), rb = __builtin_amdgcn_exp2f(tb * lb - (255.f - tb) * lf);
#pragma unroll
                        for (int e = 0; e < 8; ++e) { va[e] *= wfa; vb[e] *= wfb; }
                        tstore(va, vb, fr, fq, wid, (bf16_t*)(ws + (LATT ? WS_RKTFL : WS_RKTF)) + ((size_t)(bq * 256 + cc0) * T + t0), T);
#pragma unroll
                        for (int e = 0; e < 8; ++e) { va[e] *= ra; vb[e] *= rb; }
                        tstore(va, vb, fr, fq, wid, (bf16_t*)(ws + (LATT ? WS_RKTBL : WS_RKTB)) + ((size_t)(bq * 256 + cc0) * T + t0), T);
                    }
                    asm volatile("" ::: "memory");
                }
        }
        if (TYPE != 0 && TYPE != 4 && !(TYPE == 3 && LATT))
#pragma unroll
        for (int ai = 0; ai < 2; ++ai)
#pragma unroll
            for (int m = 0; m < 4; ++m) {
                int row = u.pm * 256 + ai * 128 + wr * 64 + m * 16 + fr;
                asm volatile("" : "+v"(row));
                int b, t;
                if (LATT) { const int r2 = row - NCTX; b = r2 >> 11; t = r2 & 2047; } else { b = row >> 8; t = row & 255; }
                float v[8];
#pragma unroll
                for (int e = 0; e < 8; ++e) v[e] = acc[ai][BJ][m][e >> 2][e & 3];
                if (LATT && (TYPE == 2 || TYPE == 6 || TYPE == 7)) rope8(v, t, wc, fq);
                if (TYPE == 0) {
                    const int seg = cb >= 256 ? 1 : 0, ch = c0 - seg * 256;
                    bf16_t* dst = LATT ? (bf16_t*)(ws + WS_UTL) + ((size_t)seg * 4 * 256 * 2048 + (size_t)(b * 256 + ch) * 2048 + t)
                                       : (bf16_t*)(ws + WS_UTC) + ((size_t)(b * 256 + ch) * 512 + seg * 256 + t);
#pragma unroll
                    for (int e = 0; e < 8; ++e) dst[(size_t)e * (LATT ? 2048 : 512)] = f2bf(v[e]);
                } else if (TYPE == 1 || TYPE == 5 || TYPE == 9) {
                    bf16_t* dst = TYPE == 1 ? (bf16_t*)(ws + WS_FZ) + (size_t)row * 256 + (c0 - 512) : TYPE == 5 ? (bf16_t*)(ws + WS_RZ) + (size_t)row * 256 + (c0 - 1536)
                                                                                                                  : (bf16_t*)(ws + WS_AZ) + (size_t)row * 512 + (c0 - 2560);
                    u32x4 w; w.x = pk2(silu_f(v[0]), silu_f(v[1])); w.y = pk2(silu_f(v[2]), silu_f(v[3])); w.z = pk2(silu_f(v[4]), silu_f(v[5])); w.w = pk2(silu_f(v[6]), silu_f(v[7]));
                    *(u32x4*)dst = w;
                } else if (TYPE == 2) {
                    bf16_t* dst = (bf16_t*)(ws + WS_RQ) + (size_t)row * 256 + (c0 - 768);
                    u32x4 w; w.x = pk2(v[0], v[1]); w.y = pk2(v[2], v[3]); w.z = pk2(v[4], v[5]); w.w = pk2(v[6], v[7]);
                    *(u32x4*)dst = w;
                } else if (TYPE == 3) {
                    const int cc = c0 - 1024;
#pragma unroll
                    for (int e = 0; e < 8; ++e) v[e] *= 0.125f;
                    bf16_t* dst = (bf16_t*)(ws + WS_RK) + (size_t)row * 256 + cc;
                    u32x4 w; w.x = pk2(v[0], v[1]); w.y = pk2(v[2], v[3]); w.z = pk2(v[4], v[5]); w.w = pk2(v[6], v[7]);
                    *(u32x4*)dst = w;
                } else if (TYPE == 4) {
                    const int cc = c0 - 1280;
                    bf16_t* dst = (bf16_t*)(ws + WS_RVT) + (LATT ? (size_t)2 * 1024 * 1024 : 0) + ((size_t)(b * 256 + cc) * T + t);
#pragma unroll
                    for (int e = 0; e < 8; ++e) dst[(size_t)e * T] = f2bf(v[e]);
                } else if (TYPE == 6) {
                    bf16_t* dst = (bf16_t*)(ws + WS_AQ) + (size_t)row * 512 + (c0 - 1792);
                    u32x4 w; constexpr float QS = 0.125f * LOG2E; w.x = pk2(v[0] * QS, v[1] * QS); w.y = pk2(v[2] * QS, v[3] * QS); w.z = pk2(v[4] * QS, v[5] * QS); w.w = pk2(v[6] * QS, v[7] * QS);
                    *(u32x4*)dst = w;
                } else if (TYPE == 7) {
                    const int cc = c0 - 2304;
                    bf16_t* dst = (bf16_t*)(ws + WS_AK) + (size_t)row * 128 + cc;
                    u32x4 w; w.x = pk2(v[0], v[1]); w.y = pk2(v[2], v[3]); w.z = pk2(v[4], v[5]); w.w = pk2(v[6], v[7]);
                    *(u32x4*)dst = w;
                    if (!LATT) { float* o = out + O_CK + ((size_t)((b * 2 + layer) * 256 + t) * 128 + cc);
                        *(f32x4*)o = (f32x4){v[0], v[1], v[2], v[3]}; *(f32x4*)(o + 4) = (f32x4){v[4], v[5], v[6], v[7]}; }
                } else if (TYPE == 8) {
                    const int cc = c0 - 2432;
                    if (!LATT) { float* o = out + O_CV + ((size_t)((b * 2 + layer) * 256 + t) * 128 + cc);
                        *(f32x4*)o = (f32x4){v[0], v[1], v[2], v[3]}; *(f32x4*)(o + 4) = (f32x4){v[4], v[5], v[6], v[7]}; }
                } else {
                    unsigned q[8];
#pragma unroll
                    for (int e = 0; e < 8; ++e) { float g = rintf(sigm_f(v[e]) * 255.f); g = fminf(fmaxf(g, 1.f), 255.f); q[e] = (unsigned)g; }
                    u32x2 w; w.x = q[0] | (q[1] << 8) | (q[2] << 16) | (q[3] << 24); w.y = q[4] | (q[5] << 8) | (q[6] << 16) | (q[7] << 24);
                    *(u32x2*)(ws + WS_MG8 + (size_t)row * 3072 + (c0 - 3072)) = w;
                }
                asm volatile("" ::: "memory");
            }
    }
    template <int BJ, bool LATT>
    DI void tile_bj(const f32x4 (&acc)[2][2][4][2], const Unit& u, int wr, int wc, int fr, int fq) const {
        const int cb = colperm(u.pn) * 256 + BJ * 128;
        if (cb >= 3072) tile<BJ, 10, LATT>(acc, u, wr, wc, fr, fq);
        else if (cb < 512) tile<BJ, 0, LATT>(acc, u, wr, wc, fr, fq);
        else if (cb < 768) tile<BJ, 1, LATT>(acc, u, wr, wc, fr, fq);
        else if (cb < 1024) tile<BJ, 2, LATT>(acc, u, wr, wc, fr, fq);
        else if (cb < 1280) tile<BJ, 3, LATT>(acc, u, wr, wc, fr, fq);
        else if (cb < 1536) tile<BJ, 4, LATT>(acc, u, wr, wc, fr, fq);
        else if (cb < 1792) tile<BJ, 5, LATT>(acc, u, wr, wc, fr, fq);
        else if (cb < 2304) tile<BJ, 6, LATT>(acc, u, wr, wc, fr, fq);
        else if (cb < 2432) tile<BJ, 7, LATT>(acc, u, wr, wc, fr, fq);
        else if (cb < 2560) tile<BJ, 8, LATT>(acc, u, wr, wc, fr, fq);
        else tile<BJ, 9, LATT>(acc, u, wr, wc, fr, fq);
    }
    DI void operator()(const f32x4 (&acc)[2][2][4][2], const Unit& u, int wr, int wc, int fr_, int fq_) const {
        int fr = fr_, fq = fq_; asm volatile("" : "+v"(fr), "+v"(fq));
        if (u.pm >= 32) { tile_bj<0, true>(acc, u, wr, wc, fr, fq); tile_bj<1, true>(acc, u, wr, wc, fr, fq); }
        else { tile_bj<0, false>(acc, u, wr, wc, fr, fq); tile_bj<1, false>(acc, u, wr, wc, fr, fq); }
    }
};

struct EpiDft {
    static constexpr bool PERM = true, AFTER_DRAIN = false, HOOK = false;
    const bf16_t* FZ; bf16_t* Y; int tokbase, T;
    DI void operator()(const f32x4 (&acc)[2][2][4][2], const Unit& u, int wr, int wc, int fr_, int fq_) const {
        int fr = fr_, fq = fq_; asm volatile("" : "+v"(fr), "+v"(fq));
#pragma unroll
        for (int ai = 0; ai < 2; ++ai)
#pragma unroll
            for (int m = 0; m < 4; ++m) {
                const size_t tok = (size_t)tokbase + (size_t)u.pn * T + u.pm * 256 + ai * 128 + wr * 64 + m * 16 + fr;
#pragma unroll
                for (int bj = 0; bj < 2; ++bj) {
                    const int col = bj * 128 + wc * 32 + 8 * fq;
                    const u32x4 z = *(const u32x4*)(FZ + tok * 256 + col);
                    const f32x4 a0 = acc[ai][bj][m][0], a1 = acc[ai][bj][m][1];
                    u32x4 w; w.x = pk2(a0[0] * bflo(z.x), a0[1] * bfhi(z.x)); w.y = pk2(a0[2] * bflo(z.y), a0[3] * bfhi(z.y));
                    w.z = pk2(a1[0] * bflo(z.z), a1[1] * bfhi(z.z)); w.w = pk2(a1[2] * bflo(z.w), a1[3] * bfhi(z.w));
                    *(u32x4*)(Y + tok * 1024 + col) = w;
                }
            }
    }
};

struct EpiDftHalf {
    static constexpr bool PERM = true, AFTER_DRAIN = true, HOOK = false;
    const bf16_t* FZ; bf16_t* Y; bf16_t* PART; unsigned* cnt; int half;
    DI void fused(const f32x4 (&acc)[2][2][4][2], const Unit& u, int wr, int wc, int fr_, int fq_, LAS unsigned char* lds, int wid, int lane) const {
        int fr = fr_, fq = fq_; asm volatile("" : "+v"(fr), "+v"(fq));
        const int tid = wid * 64 + lane, tile = u.pn * 4 + u.pm;
        u32x2* mine = (u32x2*)PART + (size_t)(tile * 4 + half) * 32 * 512 + tid;
#pragma unroll
        for (int ai = 0; ai < 2; ++ai)
#pragma unroll
            for (int bj = 0; bj < 2; ++bj)
#pragma unroll
                for (int m = 0; m < 4; ++m)
#pragma unroll
                    for (int n = 0; n < 2; ++n) { const f32x4 a = acc[ai][bj][m][n]; mine[(size_t)((((ai * 2 + bj) * 4 + m) * 2 + n)) * 512] = (u32x2){pk2(a[0], a[1]), pk2(a[2], a[3])}; }
        asm volatile("s_waitcnt vmcnt(0)" ::: "memory");
        __syncthreads();
        volatile LAS unsigned* flag = (volatile LAS unsigned*)(lds + 64);
        if (tid == 0) {
            __builtin_amdgcn_fence(__ATOMIC_RELEASE, "agent"); asm volatile("s_waitcnt vmcnt(0)" ::: "memory");
            const unsigned old = __hip_atomic_fetch_add(cnt + tile, 1u, __ATOMIC_RELAXED, __HIP_MEMORY_SCOPE_AGENT);
            if (old == 3u) { __builtin_amdgcn_fence(__ATOMIC_ACQUIRE, "agent"); asm volatile("s_waitcnt vmcnt(0)" ::: "memory"); }
            flag[0] = old;
        }
        __syncthreads();
        if (flag[0] != 3u) return;
        const float sm = half < 2 ? 1.f : -1.f;
        const u32x2* o1p = (const u32x2*)PART + (size_t)(tile * 4 + ((half + 1) & 3)) * 32 * 512 + tid; const float s1 = ((half + 1) & 3) < 2 ? 1.f : -1.f;
        const u32x2* o2p = (const u32x2*)PART + (size_t)(tile * 4 + ((half + 2) & 3)) * 32 * 512 + tid; const float s2 = ((half + 2) & 3) < 2 ? 1.f : -1.f;
        const u32x2* o3p = (const u32x2*)PART + (size_t)(tile * 4 + ((half + 3) & 3)) * 32 * 512 + tid; const float s3 = ((half + 3) & 3) < 2 ? 1.f : -1.f;
#pragma unroll
        for (int ai = 0; ai < 2; ++ai)
#pragma unroll
            for (int m = 0; m < 4; ++m) {
                int k = u.pm * 256 + ai * 128 + wr * 64 + m * 16 + fr; asm volatile("" : "+v"(k));
                const size_t tok = (size_t)NCTX + (size_t)u.pn * 2048 + k;
                const size_t tokm = (size_t)NCTX + (size_t)u.pn * 2048 + (k ? 2048 - k : 0);
#pragma unroll
                for (int bj = 0; bj < 2; ++bj) {
                    const int col = bj * 128 + wc * 32 + 8 * fq;
                    const u32x4 z = *(const u32x4*)(FZ + tok * 256 + col);
                    const u32x4 zm = *(const u32x4*)(FZ + tokm * 256 + col);
                    f32x4 a[2], d[2];
#pragma unroll
                    for (int n = 0; n < 2; ++n) {
                        const size_t ix = (size_t)((((ai * 2 + bj) * 4 + m) * 2 + n)) * 512;
                        const u32x2 q1 = o1p[ix], q2 = o2p[ix], q3 = o3p[ix];
                        const f32x4 p1 = (f32x4){bflo(q1.x), bfhi(q1.x), bflo(q1.y), bfhi(q1.y)}, p2 = (f32x4){bflo(q2.x), bfhi(q2.x), bflo(q2.y), bfhi(q2.y)},
                                    p3 = (f32x4){bflo(q3.x), bfhi(q3.x), bflo(q3.y), bfhi(q3.y)};
                        a[n] = (acc[ai][bj][m][n] + p1) + (p2 + p3);
                        d[n] = (acc[ai][bj][m][n] * sm + p1 * s1) + (p2 * s2 + p3 * s3);
                    }
                    u32x4 w; w.x = pk2(a[0][0] * bflo(z.x), a[0][1] * bfhi(z.x)); w.y = pk2(a[0][2] * bflo(z.y), a[0][3] * bfhi(z.y));
                    w.z = pk2(a[1][0] * bflo(z.z), a[1][1] * bfhi(z.z)); w.w = pk2(a[1][2] * bflo(z.w), a[1][3] * bfhi(z.w));
                    *(u32x4*)(Y + tok * 1024 + col) = w;
                    if (k != 0) {
                        u32x4 wm; wm.x = pk2(d[0][0] * bflo(zm.x), d[0][1] * bfhi(zm.x)); wm.y = pk2(d[0][2] * bflo(zm.y), d[0][3] * bfhi(zm.y));
                        wm.z = pk2(d[1][0] * bflo(zm.z), d[1][1] * bfhi(zm.z)); wm.w = pk2(d[1][2] * bflo(zm.w), d[1][3] * bfhi(zm.w));
                        *(u32x4*)(Y + tokm * 1024 + col) = wm;
                    }
                }
                asm volatile("" ::: "memory");
            }
    }
};

struct EpiMerge {
    static constexpr bool PERM = true, AFTER_DRAIN = false, HOOK = true;
    const unsigned char* MG8; bf16_t* MERGED;
    DI void seg(f32x4 (&acc)[2][2][4][2], const Unit& u, int t, int wr, int wc, int fr_, int fq_) const {
        int fr = fr_, fq = fq_; asm volatile("" : "+v"(fr), "+v"(fq));
        const int which = (t == 4) ? 0 : 1;
#pragma unroll
        for (int ai = 0; ai < 2; ++ai)
#pragma unroll
            for (int m = 0; m < 4; ++m) {
                const size_t row = (size_t)u.pm * 256 + ai * 128 + wr * 64 + m * 16 + fr;
#pragma unroll
                for (int bj = 0; bj < 2; ++bj) {
                    const int col = u.pn * 256 + bj * 128 + wc * 32 + 8 * fq;
                    const u32x2 ga = *(const u32x2*)(MG8 + row * 3072 + which * 1024 + col);
                    const u32x2 gb = *(const u32x2*)(MG8 + row * 3072 + (which + 1) * 1024 + col);
#pragma unroll
                    for (int e = 0; e < 8; ++e) {
                        const unsigned wa = e < 4 ? ga.x : ga.y, wb = e < 4 ? gb.x : gb.y;
                        const float fa = (float)((wa >> (8 * (e & 3))) & 255u), fb = (float)((wb >> (8 * (e & 3))) & 255u);
                        acc[ai][bj][m][e >> 2][e & 3] *= fa * __builtin_amdgcn_rcpf(fb);
                    }
                }
            }
    }
    DI void operator()(const f32x4 (&acc)[2][2][4][2], const Unit& u, int wr, int wc, int fr_, int fq_) const {
        int fr = fr_, fq = fq_; asm volatile("" : "+v"(fr), "+v"(fq));
#pragma unroll
        for (int ai = 0; ai < 2; ++ai)
#pragma unroll
            for (int m = 0; m < 4; ++m) {
                const size_t row = (size_t)u.pm * 256 + ai * 128 + wr * 64 + m * 16 + fr;
#pragma unroll
                for (int bj = 0; bj < 2; ++bj) {
                    const int col = u.pn * 256 + bj * 128 + wc * 32 + 8 * fq;
                    const u32x2 gc = *(const u32x2*)(MG8 + row * 3072 + 2048 + col);
                    float r[8];
#pragma unroll
                    for (int e = 0; e < 8; ++e) { const unsigned wcw = e < 4 ? gc.x : gc.y; r[e] = acc[ai][bj][m][e >> 2][e & 3] * ((float)((wcw >> (8 * (e & 3))) & 255u) * (1.f / 255.f)); }
                    u32x4 w; w.x = pk2(r[0], r[1]); w.y = pk2(r[2], r[3]); w.z = pk2(r[4], r[5]); w.w = pk2(r[6], r[7]);
                    *(u32x4*)(MERGED + row * 1024 + col) = w;
                }
            }
    }
};

struct EpiOut {
    static constexpr bool PERM = true, AFTER_DRAIN = false, HOOK = false;
    bf16_t* OUT;
    DI void operator()(const f32x4 (&acc)[2][2][4][2], const Unit& u, int wr, int wc, int fr_, int fq_) const {
        int fr = fr_, fq = fq_; asm volatile("" : "+v"(fr), "+v"(fq));
#pragma unroll
        for (int ai = 0; ai < 2; ++ai)
#pragma unroll
            for (int m = 0; m < 4; ++m) {
                const size_t row = (size_t)u.pm * 256 + ai * 128 + wr * 64 + m * 16 + fr;
#pragma unroll
                for (int bj = 0; bj < 2; ++bj) {
                    const int col = u.pn * 256 + bj * 128 + wc * 32 + 8 * fq;
                    const f32x4 a0 = acc[ai][bj][m][0], a1 = acc[ai][bj][m][1];
                    u32x4 w; w.x = pk2(a0[0], a0[1]); w.y = pk2(a0[2], a0[3]); w.z = pk2(a1[0], a1[1]); w.w = pk2(a1[2], a1[3]);
                    *(u32x4*)(OUT + row * 1024 + col) = w;
                }
            }
    }
};

struct OneUnit {
    Unit u;
    DI bool next(int i, Unit& o) const { if (i != 0) return false; o = u; return true; }
    DI void a_ready(const Unit&) const {}
    DI void done(const Unit&) const {}
};

DI void phase0(const Params& p, LAS unsigned char* lds) {
    const int tid = threadIdx.x, G = gridDim.x, bid = blockIdx.x;
    const size_t gtid = (size_t)bid * 512 + tid, gsz = (size_t)G * 512;
    unsigned char* ws = p.ws;
    LAS float* ctab = (LAS float*)lds;
    LAS float* sc = (LAS float*)(lds + 8192);
    LAS float* red = (LAS float*)(lds + 8192 + 20480);
    for (int j = tid; j < 2048; j += 512) ctab[j] = cosf((float)j * (6.283185307179586f / 2048.f));
    for (int i = tid; i < 5120; i += 512) { const int v = i >> 10, k = i & 1023; const float x = v == 0 ? p.c_ctx[k] : p.c[(v - 1) * 1024 + k]; sc[i] = x / (1.f + expf(-x)); }
    __syncthreads();
    if (gtid < 16) { const float x = p.ret_decay[gtid]; ((float*)(ws + WS_LG2))[gtid] = -log1pf(expf(-x)) * LOG2E; }
    for (size_t i = gtid; i < 1024; i += gsz) { const int pos = (int)(i >> 4), k = (int)(i & 15); const float inv = powf(10000.f, -(float)k / 16.f), ang = (float)pos * inv;
        ((float*)(ws + WS_ROPE))[i] = cosf(ang); ((float*)(ws + WS_ROPE))[1024 + i] = sinf(ang); }
    for (size_t i = gtid; i < 4096; i += gsz) ((bf16_t*)(ws + WS_IDENT))[i] = ((i >> 6) == (i & 63)) ? (bf16_t)0x3F80 : (bf16_t)0;
    for (size_t i = gtid; i < (size_t)2 * 2 * 65536; i += gsz) {
        const int n = (int)(i & 255), r = (int)((i >> 8) & 255), x = (int)((i >> 16) & 1), l = (int)(i >> 17);
        const int grp = r >> 6, rr = r & 63; const float* wf = p.w_four + ((size_t)l * 256 + grp * 64) * 256 + n; float s = 0.f;
        for (int m = 0; m < 64; ++m) { const int a = (rr * m) & 63; const float tr = x == 0 ? ctab[a * 32] : ctab[((a * 32) - 512) & 2047]; s += tr * wf[(size_t)m * 256]; }
        ((float*)(ws + WS_W4))[i] = s * 0.125f;
    }
    for (int it = bid; it < 192; it += G) {
        const int l = it / 96, cg0 = (it % 96) * 32, ks = tid >> 5, col = tid & 31;
        float a[5] = {0.f, 0.f, 0.f, 0.f, 0.f};
        const float* wp = p.w_mod + ((size_t)l * 1024 + ks * 64) * 3072 + cg0 + col;
#pragma unroll 1
        for (int k8 = 0; k8 < 64; k8 += 8) { float wv[8];
#pragma unroll
            for (int q = 0; q < 8; ++q) wv[q] = wp[(size_t)(k8 + q) * 3072];
#pragma unroll
            for (int q = 0; q < 8; ++q)
#pragma unroll
                for (int v = 0; v < 5; ++v) a[v] += sc[v * 1024 + ks * 64 + k8 + q] * wv[q]; }
        __syncthreads();
#pragma unroll
        for (int v = 0; v < 5; ++v) red[(ks * 5 + v) * 32 + col] = a[v];
        __syncthreads();
        if (tid < 160) { const int v = tid >> 5; float s = 0.f;
#pragma unroll
            for (int k2 = 0; k2 < 16; ++k2) s += red[(k2 * 5 + v) * 32 + col];
            ((float*)(ws + WS_MOD))[((size_t)l * 5 + v) * 3072 + cg0 + col] = s + p.b_mod[(size_t)l * 3072 + cg0 + col]; }
    }
}

DI void phase0b(const Params& p, LAS unsigned char* lds) {
    int tid_l = threadIdx.x; asm volatile("" : "+v"(tid_l));
    const int tid = tid_l, G = gridDim.x, bid = blockIdx.x;
    const size_t gtid = (size_t)bid * 512 + tid, gsz = (size_t)G * 512;
    unsigned char* ws = p.ws;
    LAS float* ctab = (LAS float*)lds;
    __syncthreads();
    for (int j = tid; j < 2048; j += 512) ctab[j] = cosf((float)j * (6.283185307179586f / 2048.f));
    __syncthreads();
    for (size_t i = gtid; i < (size_t)256 * 512 / 8; i += gsz) {
        const int k = (int)(i >> 6), t0 = (int)(i & 63) * 8; unsigned w[4];
#pragma unroll
        for (int e = 0; e < 8; e += 2) { float v2[2];
#pragma unroll
            for (int q = 0; q < 2; ++q) { const int tp = t0 + e + q, seg = tp >> 8, t = tp & 255, a = ((k * t) & 255) * 8; v2[q] = (seg ? -ctab[(a - 512) & 2047] : ctab[a]) * 0.0625f; }
            w[e >> 1] = pk2(v2[0], v2[1]); }
        *(u32x4*)((bf16_t*)(ws + WS_TABC) + i * 8) = (u32x4){w[0], w[1], w[2], w[3]};
    }
    for (size_t i = gtid; i < (size_t)4 * 1024 * 1024 / 8; i += gsz) {
        const int part = (int)(i >> 17), k = (int)((i >> 7) & 1023), t0 = (int)(i & 127) * 8 + (part & 1) * 1024, seg = part >> 1; unsigned w[4];
#pragma unroll
        for (int e = 0; e < 8; e += 2) { float v2[2];
#pragma unroll
            for (int q = 0; q < 2; ++q) { const int t = t0 + e + q, a = (k * t) & 2047; v2[q] = (seg ? -ctab[(a - 512) & 2047] : ctab[a]) * 0.02209708691207961f; }
            w[e >> 1] = pk2(v2[0], v2[1]); }
        *(u32x4*)((bf16_t*)(ws + WS_TABL) + i * 8) = (u32x4){w[0], w[1], w[2], w[3]};
    }
    for (size_t i = gtid; i < (size_t)2 * 4 * 2 * 512 * 64; i += gsz) {
        const int d = (int)(i & 63), s = (int)((i >> 6) & 511), kvh = (int)((i >> 15) & 1), b = (int)((i >> 16) & 3), l = (int)(i >> 18);
        const size_t src = ((((size_t)b * 2 + l) * 512 + s) * 2 + kvh) * 64 + d;
        ((bf16_t*)(ws + WS_CKB))[i] = f2bf(p.cache_k[src]);
        ((bf16_t*)(ws + WS_CVT))[((((size_t)l * 4 + b) * 2 + kvh) * 64 + d) * 512 + s] = f2bf(p.cache_v[src]);
    }
    __syncthreads();
}

DI void transpose_item(const float* src, int ld_src, bf16_t* dst, int ld_dst, int k0, int n0src, int rowdst0, int kdst0, LAS float* scr, int lane) {
#pragma unroll 8
    for (int i = 0; i < 32; ++i) { const int kk = 2 * i + (lane >> 5); scr[kk * 33 + (lane & 31)] = src[(size_t)(k0 + kk) * ld_src + n0src + (lane & 31)]; }
    LDS_WAIT();
    const int c = lane & 7;
#pragma unroll
    for (int j = 0; j < 4; ++j) { const int n = (lane >> 3) + 8 * j; const LAS float* s = scr + (8 * c) * 33 + n;
        u32x4 o; o.x = pk2(s[0 * 33], s[1 * 33]); o.y = pk2(s[2 * 33], s[3 * 33]); o.z = pk2(s[4 * 33], s[5 * 33]); o.w = pk2(s[6 * 33], s[7 * 33]);
        *(u32x4*)(dst + (size_t)(rowdst0 + n) * ld_dst + kdst0 + 8 * c) = o; }
    LDS_WAIT();
}

DI void row_pass(const Params& p, int mode) {
    int tid_l = threadIdx.x; asm volatile("" : "+v"(tid_l));
    const int lane = tid_l & 63, wave = __builtin_amdgcn_readfirstlane(tid_l >> 6);
    const int gw = blockIdx.x * 8 + wave, NGW = gridDim.x * 8;
    const float* mod = (const float*)(p.ws + WS_MOD);
    for (int row = gw; row < NTOK; row += NGW) {
        const bool lat = row >= NCTX; const int vec = lat ? 1 + ((row - NCTX) >> 11) : 0;
        const float* xin = mode == 2 ? p.out + (size_t)row * 1024 : (lat ? p.x_sample + (size_t)(row - NCTX) * 1024 : p.x_prompt + (size_t)row * 1024);
        f32x4 x[4];
        if (mode == 2) {
            const bf16_t* xb = (const bf16_t*)xin;
#pragma unroll
            for (int j = 0; j < 4; ++j) { const u32x2 v = *(const u32x2*)(xb + 4 * lane + 256 * j); x[j] = (f32x4){bflo(v.x), bfhi(v.x), bflo(v.y), bfhi(v.y)}; }
        } else {
#pragma unroll
            for (int j = 0; j < 4; ++j) x[j] = *(const f32x4*)(xin + 4 * lane + 256 * j);
        }
        if (mode != 0) {
            const int lp = mode - 1;
            const bf16_t* orow = (const bf16_t*)(p.ws + WS_OUT) + (size_t)row * 1024;
            f32x4 o[4]; float s = 0.f;
#pragma unroll
            for (int j = 0; j < 4; ++j) { const u32x2 ob = *(const u32x2*)(orow + 4 * lane + 256 * j); o[j] = (f32x4){bflo(ob.x), bfhi(ob.x), bflo(ob.y), bfhi(ob.y)};
                s += (o[j][0] * o[j][0] + o[j][1] * o[j][1]) + (o[j][2] * o[j][2] + o[j][3] * o[j][3]); }
            const float rstd = 1.f / sqrtf(wave_sum(s) * (1.f / 1024.f) + EPS);
#pragma unroll
            for (int j = 0; j < 4; ++j) {
                const f32x4 gp = *(const f32x4*)(p.g_post + (size_t)lp * 1024 + 4 * lane + 256 * j);
                const f32x4 gt = *(const f32x4*)(mod + ((size_t)lp * 5 + vec) * 3072 + 2048 + 4 * lane + 256 * j);
                x[j] = x[j] + gt * (o[j] * rstd * gp);
                if (mode == 2) *(f32x4*)(p.out + (size_t)row * 1024 + 4 * lane + 256 * j) = x[j];
                else { u32x2 w; w.x = pk2(x[j][0], x[j][1]); w.y = pk2(x[j][2], x[j][3]); *(u32x2*)((bf16_t*)(p.out + (size_t)row * 1024) + 4 * lane + 256 * j) = w; }
            }
        }
        if (mode != 2) {
            const int l = mode; float s = 0.f;
#pragma unroll
            for (int j = 0; j < 4; ++j) s += (x[j][0] * x[j][0] + x[j][1] * x[j][1]) + (x[j][2] * x[j][2] + x[j][3] * x[j][3]);
            const float rstd = 1.f / sqrtf(wave_sum(s) * (1.f / 1024.f) + EPS);
            bf16_t* hrow = (bf16_t*)(p.ws + WS_H) + (size_t)row * 1024;
#pragma unroll
            for (int j = 0; j < 4; ++j) {
                const f32x4 g = *(const f32x4*)(p.g_pre + (size_t)l * 1024 + 4 * lane + 256 * j);
                const f32x4 sh = *(const f32x4*)(mod + ((size_t)l * 5 + vec) * 3072 + 4 * lane + 256 * j);
                const f32x4 scl = *(const f32x4*)(mod + ((size_t)l * 5 + vec) * 3072 + 1024 + 4 * lane + 256 * j);
                const f32x4 hv = (x[j] * rstd * g) * (scl + 1.f) + sh;
                u32x2 w; w.x = pk2(hv[0], hv[1]); w.y = pk2(hv[2], hv[3]);
                *(u32x2*)(hrow + 4 * lane + 256 * j) = w;
            }
        }
    }
}

DI void weight_prep(const Params& p, LAS unsigned char* lds, bool do_fold, bool do_tr) {
    int tid_l = threadIdx.x; asm volatile("" : "+v"(tid_l));
    const int tid = tid_l, lane = tid & 63, wave = __builtin_amdgcn_readfirstlane(tid >> 6), G = gridDim.x;
    unsigned char* ws = p.ws;
    LAS float* sA = (LAS float*)lds; LAS float* sB = sA + 64 * 129;
    if (do_fold)
    for (int it0 = blockIdx.x; it0 < 256; it0 += G) {
        const int l = it0 >> 7, it = it0 & 127; bf16_t* WinT = (bf16_t*)(ws + WS_WINT + wl(l));
        const int dt = it >> 3, nt8 = it & 7, x = nt8 >> 2, n0 = (nt8 & 3) * 64;
        const float* W4 = (const float*)(ws + WS_W4) + ((size_t)l * 2 + x) * 65536;
        const float* wi = p.w_in + (size_t)l * 1024 * WIN_LD + (size_t)dt * 64 * WIN_LD;
        float a[8] = {0.f, 0.f, 0.f, 0.f, 0.f, 0.f, 0.f, 0.f};
        const int d = tid >> 3, ng = tid & 7;
        for (int half = 0; half < 2; ++half) {
            __syncthreads();
            for (int i = tid; i < 8192; i += 512) { const int dd = i >> 7, r = i & 127; sA[dd * 129 + r] = wi[(size_t)dd * WIN_LD + half * 128 + r]; }
            for (int i = tid; i < 8192; i += 512) { const int r = i >> 6, n = i & 63; sB[r * 64 + n] = W4[(size_t)(half * 128 + r) * 256 + n0 + n]; }
            __syncthreads();
            for (int r = 0; r < 128; ++r) { const float av = sA[d * 129 + r]; const LAS float* bp = sB + r * 64 + ng * 8;
#pragma unroll
                for (int e = 0; e < 8; ++e) a[e] += av * bp[e]; }
        }
#pragma unroll
        for (int e = 0; e < 8; ++e) WinT[(size_t)(x * 256 + n0 + ng * 8 + e) * 1024 + dt * 64 + d] = f2bf(a[e]);
    }
    __syncthreads();
    LAS float* scr = (LAS float*)(lds + wave * 8704);
    const int gw = blockIdx.x * 8 + wave, NGW = G * 8;
    if (do_tr)
    for (int it = gw; it < 7680; it += NGW) {
        const int l = it / 3840; int r = it % 3840; bf16_t* WinT = (bf16_t*)(ws + WS_WINT + wl(l));
        if (r < 2816) { const int kb = r / 176, nb = r % 176; const int lrow = 512 + 32 * nb, prow = colperm(lrow >> 8) * 256 + (lrow & 255); transpose_item(p.w_in + (size_t)l * 1024 * WIN_LD, WIN_LD, WinT, 1024, 64 * kb, 256 + 32 * nb, prow, 64 * kb, scr, lane); continue; } r -= 2816;
        if (r < 128) { const int kb = r >> 5, nb = r & 31; transpose_item(p.w_pa + (size_t)l * 256 * 1024, 1024, (bf16_t*)(ws + WS_WBRT + wl(l)), 1024, 64 * kb, 32 * nb, 32 * nb, 64 * kb, scr, lane); continue; } r -= 128;
        if (r < 128) { const int kb = r >> 5, nb = r & 31; transpose_item(p.w_pb + (size_t)l * 256 * 1024, 1024, (bf16_t*)(ws + WS_WBRT + wl(l)), 1024, 64 * kb, 32 * nb, 32 * nb, 256 + 64 * kb, scr, lane); continue; } r -= 128;
        if (r < 256) { const int kb = r >> 5, nb = r & 31; transpose_item(p.w_pc + (size_t)l * 512 * 1024, 1024, (bf16_t*)(ws + WS_WBRT + wl(l)), 1024, 64 * kb, 32 * nb, 32 * nb, 512 + 64 * kb, scr, lane); continue; } r -= 256;
        { const int kb = r >> 5, nb = r & 31; transpose_item(p.w_out + (size_t)l * 1024 * 1024, 1024, (bf16_t*)(ws + WS_WOUTT + wl(l)), 1024, 64 * kb, 32 * nb, 32 * nb, 64 * kb, scr, lane); }
    }
}

constexpr int FK_STRIDE = 144, FV_STRIDE = 136, FV_OFF = 64 * FK_STRIDE, FBUF = 64 * FK_STRIDE + 64 * FV_STRIDE;
struct TileSrc { const bf16_t* k; int kld; const bf16_t* vt; int vld; };

DI void flash_load(const TileSrc& s, u32x4& kr, u32x4& vr, int tid) {
    const int row = tid >> 3, ch = tid & 7;
    kr = *(const u32x4*)(s.k + (size_t)row * s.kld + ch * 8);
    vr = *(const u32x4*)(s.vt + (size_t)row * s.vld + ch * 8);
}
DI void flash_store(LAS unsigned char* buf, const u32x4& kr, const u32x4& vr, int tid) {
    const int row = tid >> 3, ch = tid & 7;
    *(LAS u32x4*)(buf + row * FK_STRIDE + ch * 16) = kr;
    LAS u32x2* vp = (LAS u32x2*)(buf + FV_OFF + row * FV_STRIDE + ch * 16);
    vp[0] = (u32x2){vr.x, vr.y}; vp[1] = (u32x2){vr.z, vr.w};
}
DI void flash_qk(const LAS unsigned char* buf, const bf16x8 (&qf)[4], f32x16& s0, f32x16& s1, int r32, int hh) {
#pragma unroll
    for (int kk = 0; kk < 4; ++kk) {
        const bf16x8 a0 = *(const LAS bf16x8*)(buf + r32 * FK_STRIDE + (16 * kk + 8 * hh) * 2);
        const bf16x8 a1 = *(const LAS bf16x8*)(buf + (32 + r32) * FK_STRIDE + (16 * kk + 8 * hh) * 2);
        s0 = MFMA32(a0, qf[kk], s0); s1 = MFMA32(a1, qf[kk], s1);
    }
}
DI void flash_kload(const LAS unsigned char* buf, bf16x8 (&a0)[4], bf16x8 (&a1)[4], int r32, int hh) {
#pragma unroll
    for (int kk = 0; kk < 4; ++kk) {
        a0[kk] = *(const LAS bf16x8*)(buf + r32 * FK_STRIDE + (16 * kk + 8 * hh) * 2);
        a1[kk] = *(const LAS bf16x8*)(buf + (32 + r32) * FK_STRIDE + (16 * kk + 8 * hh) * 2);
    }
}
DI void flash_qk_pre(const bf16x8 (&a0)[4], const bf16x8 (&a1)[4], const bf16x8 (&qf)[4], f32x16& s0, f32x16& s1) {
#pragma unroll
    for (int kk = 0; kk < 4; ++kk) { s0 = MFMA32(a0[kk], qf[kk], s0); s1 = MFMA32(a1[kk], qf[kk], s1); }
}
DI void flash_vload(const LAS unsigned char* buf, bf16x8 (&va)[4][2], int r32, int hh) {
#pragma unroll
    for (int s = 0; s < 4; ++s)
#pragma unroll
        for (int db = 0; db < 2; ++db) {
            const LAS unsigned char* vp = buf + FV_OFF + (32 * db + r32) * FV_STRIDE + (16 * s + 4 * hh) * 2;
            const u32x2 lo = *(const LAS u32x2*)vp, hi = *(const LAS u32x2*)(vp + 16);
            va[s][db] = __builtin_bit_cast(bf16x8, ((u32x4){lo.x, lo.y, hi.x, hi.y}));
        }
}
DI bf16x8 pack8(float a0, float a1, float a2, float a3, float a4, float a5, float a6, float a7) {
    u32x4 w; w.x = pk2(a0, a1); w.y = pk2(a2, a3); w.z = pk2(a4, a5); w.w = pk2(a6, a7); return __builtin_bit_cast(bf16x8, w);
}
DI void flash_pv_step(const LAS unsigned char* buf, int s, const bf16x8& pf, f32x16& o0, f32x16& o1, int r32, int hh) {
#pragma unroll
    for (int db = 0; db < 2; ++db) {
        const LAS unsigned char* vp = buf + FV_OFF + (32 * db + r32) * FV_STRIDE + (16 * s + 4 * hh) * 2;
        const u32x2 lo = *(const LAS u32x2*)vp, hi = *(const LAS u32x2*)(vp + 16);
        const bf16x8 va = __builtin_bit_cast(bf16x8, ((u32x4){lo.x, lo.y, hi.x, hi.y}));
        if (db == 0) o0 = MFMA32(va, pf, o0); else o1 = MFMA32(va, pf, o1);
    }
}
DI void flash_pv_pre(const bf16x8 (&va)[4][2], const f32x16& p0, const f32x16& p1, f32x16& o0, f32x16& o1) {
    const bf16x8 f0 = pack8(p0[0], p0[1], p0[2], p0[3], p0[4], p0[5], p0[6], p0[7]), f1 = pack8(p0[8], p0[9], p0[10], p0[11], p0[12], p0[13], p0[14], p0[15]);
    const bf16x8 f2 = pack8(p1[0], p1[1], p1[2], p1[3], p1[4], p1[5], p1[6], p1[7]), f3 = pack8(p1[8], p1[9], p1[10], p1[11], p1[12], p1[13], p1[14], p1[15]);
    o0 = MFMA32(va[0][0], f0, o0); o1 = MFMA32(va[0][1], f0, o1);
    o0 = MFMA32(va[1][0], f1, o0); o1 = MFMA32(va[1][1], f1, o1);
    o0 = MFMA32(va[2][0], f2, o0); o1 = MFMA32(va[2][1], f2, o1);
    o0 = MFMA32(va[3][0], f3, o0); o1 = MFMA32(va[3][1], f3, o1);
}
DI void flash_pv(const LAS unsigned char* buf, const f32x16& p0, const f32x16& p1, f32x16& o0, f32x16& o1, int r32, int hh) {
    flash_pv_step(buf, 0, pack8(p0[0], p0[1], p0[2], p0[3], p0[4], p0[5], p0[6], p0[7]), o0, o1, r32, hh);
    flash_pv_step(buf, 1, pack8(p0[8], p0[9], p0[10], p0[11], p0[12], p0[13], p0[14], p0[15]), o0, o1, r32, hh);
    flash_pv_step(buf, 2, pack8(p1[0], p1[1], p1[2], p1[3], p1[4], p1[5], p1[6], p1[7]), o0, o1, r32, hh);
    flash_pv_step(buf, 3, pack8(p1[8], p1[9], p1[10], p1[11], p1[12], p1[13], p1[14], p1[15]), o0, o1, r32, hh);
}

template <bool LAT>
DI void attn_unit(const Params& p, LAS unsigned char* lds, int layer, int b, int kvh, int qb) {
    constexpr int T = LAT ? 2048 : 256;
    int tid_l = threadIdx.x; asm volatile("" : "+v"(tid_l));
    const int tid = tid_l, w = __builtin_amdgcn_readfirstlane(tid >> 6), l = tid & 63, r32 = l & 31, hh = l >> 5;
    const unsigned char* ws = p.ws;
    const int tokbase = LAT ? NCTX + b * 2048 : b * 256;
    const int head = kvh * 4 + (w >> 1);
    const int myq = qb * 64 + (w & 1) * 32 + r32;
    bf16x8 qf[4];
    { const bf16_t* qp = (const bf16_t*)(ws + WS_AQ) + (size_t)(tokbase + myq) * 512 + head * 64 + 8 * hh;
#pragma unroll
      for (int kk = 0; kk < 4; ++kk) qf[kk] = *(const bf16x8*)(qp + 16 * kk); }
    float mrun = p.attn_sink[layer * 8 + head] * LOG2E;
    float lsum = hh == 0 ? 1.f : 0.f;
    f32x16 o0, o1;
#pragma unroll
    for (int i = 0; i < 16; ++i) { o0[i] = 0.f; o1[i] = 0.f; }
    int jlo = 0, nloc = 4;
    if (LAT) { jlo = qb < 2 ? 2 - qb : 0; int jhi = 33 - qb; if (jhi > 4) jhi = 4; nloc = jhi - jlo + 1; }
    const int ntile = LAT ? nloc + 8 : nloc;
    const bf16_t* AK = (const bf16_t*)(ws + WS_AK); const bf16_t* AVT = (const bf16_t*)(ws + WS_AVT) + (LAT ? (size_t)1024 * 1024 : 0);
    const bf16_t* CK = (const bf16_t*)(ws + WS_CKB) + (size_t)((layer * 4 + b) * 2 + kvh) * 512 * 64;
    const bf16_t* CV = (const bf16_t*)(ws + WS_CVT) + (size_t)((layer * 4 + b) * 2 + kvh) * 64 * 512;
    auto src_of = [&](int i, int& key0, bool& local) -> TileSrc {
        TileSrc s;
        if (i < nloc) { key0 = LAT ? qb * 64 - 128 + 64 * (jlo + i) : 64 * i; local = true;
            s.k = AK + (size_t)(tokbase + key0) * 128 + kvh * 64; s.kld = 128; s.vt = AVT + (size_t)((b * 2 + kvh) * 64) * T + key0; s.vld = T; }
        else { key0 = 64 * (i - nloc); local = false; s.k = CK + (size_t)key0 * 64; s.kld = 64; s.vt = CV + key0; s.vld = 512; }
        return s;
    };
    u32x4 kr, vr; int key0; bool local;
    { const TileSrc s = src_of(0, key0, local); flash_load(s, kr, vr, tid); flash_store(lds, kr, vr, tid); }
    for (int i = 0; i < ntile; ++i) {
        __syncthreads();
        const LAS unsigned char* buf = lds + (i & 1) * FBUF;
        int k0n; bool locn;
        if (i + 1 < ntile) { const TileSrc s = src_of(i + 1, k0n, locn); flash_load(s, kr, vr, tid); }
        { int kd; bool ld_; (void)src_of(i, kd, ld_); key0 = kd; local = ld_; }
        f32x16 s0, s1;
        { const float nm = -mrun;
#pragma unroll
          for (int r = 0; r < 16; ++r) { s0[r] = nm; s1[r] = nm; } }
        bf16x8 ka0[4], ka1[4]; flash_kload(buf, ka0, ka1, r32, hh);
        __builtin_amdgcn_sched_barrier(0);
        flash_qk_pre(ka0, ka1, qf, s0, s1);
        bf16x8 va[4][2]; flash_vload(buf, va, r32, hh);
        __builtin_amdgcn_sched_barrier(0);
        if (LAT && local && (jlo + i == 0 || jlo + i == 4)) {
#pragma unroll
            for (int r = 0; r < 16; ++r) { const int kp = key0 + crow(r, hh); int d0 = myq - kp; d0 = d0 < 0 ? -d0 : d0; int d1 = myq - kp - 32; d1 = d1 < 0 ? -d1 : d1;
                if (d0 > 128) s0[r] = -INFINITY; if (d1 > 128) s1[r] = -INFINITY; }
        }
        float mx = fmaxf(s0[0], s1[0]);
#pragma unroll
        for (int r = 1; r < 16; ++r) mx = fmaxf(fmaxf(mx, s0[r]), s1[r]);
        mx = fmaxf(mx, __shfl_xor(mx, 32));
        if (__builtin_amdgcn_ballot_w64(mx > 8.f) != 0ull) {
            const float inc = fmaxf(mx, 0.f), alpha = __builtin_amdgcn_exp2f(-inc);
            mrun += inc; lsum *= alpha; o0 = o0 * alpha; o1 = o1 * alpha;
            s0 = s0 - inc; s1 = s1 - inc;
        }
        float rs = 0.f;
#pragma unroll
        for (int r = 0; r < 16; ++r) { s0[r] = __builtin_amdgcn_exp2f(s0[r]); s1[r] = __builtin_amdgcn_exp2f(s1[r]); rs += s0[r] + s1[r]; }
        lsum += rs;
        flash_pv_pre(va, s0, s1, o0, o1);
        if (i + 1 < ntile) flash_store(lds + ((i + 1) & 1) * FBUF, kr, vr, tid);
    }
    const float ltot = lsum + __shfl_xor(lsum, 32), inv = 1.f / ltot;
    const bf16_t* AZ = (const bf16_t*)(ws + WS_AZ) + (size_t)(tokbase + myq) * 512 + head * 64;
    bf16_t* Y = (bf16_t*)(p.ws + WS_H) + (size_t)(tokbase + myq) * 1024 + 512 + head * 64;
#pragma unroll
    for (int db = 0; db < 2; ++db)
#pragma unroll
        for (int g4 = 0; g4 < 4; ++g4) {
            const int d = 32 * db + 8 * g4 + 4 * hh;
            const u32x2 z = *(const u32x2*)(AZ + d);
            const f32x16& o = db == 0 ? o0 : o1;
            u32x2 wv; wv.x = pk2(o[4 * g4] * inv * bflo(z.x), o[4 * g4 + 1] * inv * bfhi(z.x)); wv.y = pk2(o[4 * g4 + 2] * inv * bflo(z.y), o[4 * g4 + 3] * inv * bfhi(z.y));
            *(u32x2*)(Y + d) = wv;
        }
}

template <bool LAT>
DI void ret_unit(const Params& p, LAS unsigned char* lds, int layer, int b, int h, int qb, unsigned* flag) {
    constexpr int T = LAT ? 2048 : 256;
    int tid_l = threadIdx.x; asm volatile("" : "+v"(tid_l));
    const int tid = tid_l, w = __builtin_amdgcn_readfirstlane(tid >> 6), l = tid & 63, r32 = l & 31, hh = l >> 5;
    const unsigned char* ws = p.ws; asm volatile("" : "+s"(ws));
    const int tokbase = LAT ? NCTX + b * 2048 : b * 256;
    const int myq = qb * 256 + w * 32 + r32;
    const float* lg2 = (const float*)(ws + WS_LG2);
    const float lf = lg2[layer * 8 + h], lb = lg2[layer * 8 + 4 + h];
    bf16x8 qf[4];
    { const bf16_t* qp = (const bf16_t*)(ws + WS_RQ) + (size_t)(tokbase + myq) * 256 + h * 64 + 8 * hh;
#pragma unroll
      for (int kk = 0; kk < 4; ++kk) qf[kk] = *(const bf16x8*)(qp + 16 * kk); }
    f32x16 o0, o1;
#pragma unroll
    for (int i = 0; i < 16; ++i) { o0[i] = 0.f; o1[i] = 0.f; }
    f32x16 cf, cbk;
#pragma unroll
    for (int r = 0; r < 16; ++r) { cf[r] = __builtin_amdgcn_exp2f(-(float)crow(r, hh) * lf); cbk[r] = __builtin_amdgcn_exp2f((float)crow(r, hh) * lb); }
    const float g32f = __builtin_amdgcn_exp2f(-32.f * lf), g32b = __builtin_amdgcn_exp2f(32.f * lb);
    constexpr int nreal = 4;
    const int ntile = LAT ? nreal + 2 : nreal;
    if (LAT) {
        if (tid == 0) { unsigned sp = 0; while (__hip_atomic_load(flag, __ATOMIC_RELAXED, __HIP_MEMORY_SCOPE_AGENT) < 2u) { __builtin_amdgcn_s_sleep(4); if (++sp > (1u << 22)) break; }
            __builtin_amdgcn_fence(__ATOMIC_ACQUIRE, "agent"); asm volatile("s_waitcnt vmcnt(0)" ::: "memory"); }
        __syncthreads();
    }
    const bf16_t* RK = (const bf16_t*)(ws + WS_RK) + (size_t)tokbase * 256 + h * 64;
    const bf16_t* RVT = (const bf16_t*)(ws + WS_RVT) + (LAT ? (size_t)2 * 1024 * 1024 : 0) + (size_t)((b * 4 + h) * 64) * T;
    const bf16_t* ID = (const bf16_t*)(ws + WS_IDENT);
    const bf16_t* S0 = (const bf16_t*)(ws + WS_SCH) + (size_t)((((b * 4 + h) * 8 + qb) * 2)) * 4096;
    auto src_of = [&](int i) -> TileSrc {
        TileSrc s;
        if (i < nreal) { s.k = RK + (size_t)(qb * 256 + 64 * i) * 256; s.kld = 256; s.vt = RVT + qb * 256 + 64 * i; s.vld = T; }
        else { s.k = ID; s.kld = 64; s.vt = S0 + (size_t)(i - nreal) * 4096; s.vld = 64; }
        return s;
    };
    u32x4 kr, vr;
    { const TileSrc s = src_of(0); flash_load(s, kr, vr, tid); flash_store(lds, kr, vr, tid); }
    for (int i = 0; i < ntile; ++i) {
        __syncthreads();
        const LAS unsigned char* buf = lds + (i & 1) * FBUF;
        if (i + 1 < ntile) { const TileSrc s = src_of(i + 1); flash_load(s, kr, vr, tid); }
        f32x16 s0, s1;
#pragma unroll
        for (int r = 0; r < 16; ++r) { s0[r] = 0.f; s1[r] = 0.f; }
        flash_qk(buf, qf, s0, s1, r32, hh);
        if (i < nreal) {
            const int key0 = qb * 256 + 64 * i, qw = qb * 256 + w * 32;
            if (key0 + 63 < qw) {
                const float E = __builtin_amdgcn_exp2f((float)(myq - key0) * lf);
                s0 = s0 * cf * E; s1 = s1 * cf * (E * g32f);
            } else if (key0 > qw + 31) {
                const float E = __builtin_amdgcn_exp2f((float)(key0 - myq) * lb);
                s0 = s0 * cbk * E; s1 = s1 * cbk * (E * g32b);
            } else {
                const int dq = myq - key0;
                const float Ef = __builtin_amdgcn_exp2f((float)dq * lf), Eb = __builtin_amdgcn_exp2f(-(float)dq * lb);
                const f32x16 vf0 = cf * Ef, vb0 = cbk * Eb, vf1 = cf * (Ef * g32f), vb1 = cbk * (Eb * g32b);
#pragma unroll
                for (int r = 0; r < 16; ++r) {
                    const int d0 = dq - crow(r, hh), d1 = d0 - 32;
                    const float f0 = d0 > 0 ? vf0[r] : (d0 < 0 ? vb0[r] : 2.f);
                    const float f1 = d1 > 0 ? vf1[r] : (d1 < 0 ? vb1[r] : 2.f);
                    s0[r] *= f0; s1[r] *= f1;
                }
            }
        } else {
            const int pl = w * 32 + r32;
            const float f = (i == nreal) ? __builtin_amdgcn_exp2f((float)(pl + 1) * lf) : __builtin_amdgcn_exp2f((float)(256 - pl) * lb);
#pragma unroll
            for (int r = 0; r < 16; ++r) { s0[r] *= f; s1[r] *= f; }
        }
        flash_pv(buf, s0, s1, o0, o1, r32, hh);
        if (i + 1 < ntile) flash_store(lds + ((i + 1) & 1) * FBUF, kr, vr, tid);
    }
    float ss = 0.f;
#pragma unroll
    for (int r = 0; r < 16; ++r) ss += o0[r] * o0[r] + o1[r] * o1[r];
    ss += __shfl_xor(ss, 32);
    const float rstd = 1.f / sqrtf(ss * (1.f / 64.f) + EPS);
    const float* gn = p.ret_gn + (size_t)layer * 256 + h * 64;
    const bf16_t* RZ = (const bf16_t*)(ws + WS_RZ) + (size_t)(tokbase + myq) * 256 + h * 64;
    bf16_t* Y = (bf16_t*)(p.ws + WS_H) + (size_t)(tokbase + myq) * 1024 + 256 + h * 64;
#pragma unroll
    for (int db = 0; db < 2; ++db)
#pragma unroll
        for (int g4 = 0; g4 < 4; ++g4) {
            const int e = 32 * db + 8 * g4 + 4 * hh;
            const u32x2 z = *(const u32x2*)(RZ + e);
            const f32x4 g = *(const f32x4*)(gn + e);
            const f32x16& o = db == 0 ? o0 : o1;
            u32x2 wv; wv.x = pk2(o[4 * g4] * rstd * g[0] * bflo(z.x), o[4 * g4 + 1] * rstd * g[1] * bfhi(z.x));
            wv.y = pk2(o[4 * g4 + 2] * rstd * g[2] * bflo(z.y), o[4 * g4 + 3] * rstd * g[3] * bfhi(z.y));
            *(u32x2*)(Y + e) = wv;
        }
    if (!LAT) {
        const int dir = w >> 2, dblk = (w >> 1) & 1, eblk = w & 1;
        const bf16_t* A = (const bf16_t*)(ws + (dir ? WS_RKTB : WS_RKTF)) + (size_t)((b * 4 + h) * 64 + 32 * dblk + r32) * 256 + 8 * hh;
        const bf16_t* B = (const bf16_t*)(ws + WS_RVT) + (size_t)((b * 4 + h) * 64 + 32 * eblk + r32) * 256 + 8 * hh;
        f32x16 acc;
#pragma unroll
        for (int r = 0; r < 16; ++r) acc[r] = 0.f;
#pragma unroll 4
        for (int s = 0; s < 16; ++s) { const bf16x8 a = *(const bf16x8*)(A + 16 * s), bb = *(const bf16x8*)(B + 16 * s); acc = MFMA32(a, bb, acc); }
        float* o = p.out + O_ST + (size_t)((((b * 2 + layer) * 2 + dir) * 4 + h)) * 4096;
#pragma unroll
        for (int r = 0; r < 16; ++r) o[(32 * dblk + crow(r, hh)) * 64 + 32 * eblk + r32] = acc[r];
    }
}

DI void ret_state_job(const Params& p, LAS unsigned char* lds, int layer, int b, int h, int dir, unsigned* flag) {
    int tid_l = threadIdx.x; asm volatile("" : "+v"(tid_l));
    const int tid = tid_l, w = __builtin_amdgcn_readfirstlane(tid >> 6), l = tid & 63, r32 = l & 31, hh = l >> 5;
    const unsigned char* ws = p.ws; asm volatile("" : "+s"(ws));
    const int dblk = (w >> 1) & 1, eblk = w & 1;
    const float g256 = __builtin_amdgcn_exp2f(256.f * ((const float*)(ws + WS_LG2))[layer * 8 + dir * 4 + h]);
    f32x16 S;
    { const float* s0 = p.state_ret + ((size_t)((((b * 2 + layer) * 2 + dir) * 4 + h)) * 64) * 64;
#pragma unroll
      for (int r = 0; r < 16; ++r) S[r] = s0[(32 * dblk + crow(r, hh)) * 64 + 32 * eblk + r32]; }
    const bf16_t* Ag = (const bf16_t*)(ws + (dir ? WS_RKTBL : WS_RKTFL)) + (size_t)((b * 4 + h) * 64) * 2048;
    const bf16_t* Bg = (const bf16_t*)(ws + WS_RVT) + (size_t)2 * 1024 * 1024 + (size_t)((b * 4 + h) * 64) * 2048;
    bf16_t* SCH = (bf16_t*)(p.ws + WS_SCH) + (size_t)((b * 4 + h) * 8) * 2 * 4096;
    constexpr int RST = 528;
#pragma unroll 1
    for (int it = 0; it < 8; ++it) {
        const int c = dir ? 7 - it : it;
        __syncthreads();
#pragma unroll
        for (int q = 0; q < 8; ++q) {
            const int idx = tid + 512 * q, img = idx >> 11, rem = idx & 2047, row = rem >> 5, pc = rem & 31;
            const u32x4 v = *(const u32x4*)((img ? Bg : Ag) + (size_t)row * 2048 + c * 256 + pc * 8);
            *(LAS u32x4*)(lds + img * 64 * RST + row * RST + pc * 16) = v;
        }
        __syncthreads();
        if (w < 4) {
            { bf16_t* o = SCH + (size_t)(c * 2 + dir) * 4096 + (size_t)(32 * eblk + r32) * 64 + 32 * dblk + 4 * hh;
#pragma unroll
              for (int g4 = 0; g4 < 4; ++g4) { u32x2 wv; wv.x = pk2(S[4 * g4], S[4 * g4 + 1]); wv.y = pk2(S[4 * g4 + 2], S[4 * g4 + 3]); *(u32x2*)(o + 8 * g4) = wv; } }
            f32x16 acc;
#pragma unroll
            for (int r = 0; r < 16; ++r) acc[r] = 0.f;
            const LAS unsigned char* ap = lds + (32 * dblk + r32) * RST + 16 * hh;
            const LAS unsigned char* bp = lds + 64 * RST + (32 * eblk + r32) * RST + 16 * hh;
#pragma unroll
            for (int s = 0; s < 16; ++s) { const bf16x8 a = *(const LAS bf16x8*)(ap + 32 * s), bb = *(const LAS bf16x8*)(bp + 32 * s); acc = MFMA32(a, bb, acc); }
            S = S * g256 + acc;
        }
    }
    asm volatile("s_waitcnt vmcnt(0)" ::: "memory");
    __syncthreads();
    if (tid == 0) { __builtin_amdgcn_fence(__ATOMIC_RELEASE, "agent"); asm volatile("s_waitcnt vmcnt(0)" ::: "memory");
        __hip_atomic_fetch_add(flag, 1u, __ATOMIC_RELAXED, __HIP_MEMORY_SCOPE_AGENT); }
}

DI void dft_nyquist_job(const Params& p, int b) {
    int tid_l = threadIdx.x; asm volatile("" : "+v"(tid_l));
    const int tid = tid_l, w = __builtin_amdgcn_readfirstlane(tid >> 6), l = tid & 63;
    const bf16_t* U = (const bf16_t*)(p.ws + WS_UTL) + (size_t)(b * 256) * 1024;
    const size_t tok = (size_t)NCTX + (size_t)b * 2048 + 1024;
    const bf16_t* FZ = (const bf16_t*)(p.ws + WS_FZ) + tok * 256; bf16_t* Y = (bf16_t*)(p.ws + WS_H) + tok * 1024;
#pragma unroll 1
    for (int c = 0; c < 32; ++c) {
        const int ch = w * 32 + c; float s = 0.f;
#pragma unroll
        for (int q = 0; q < 4; ++q) { const u32x4 v = *(const u32x4*)(U + (size_t)((q >> 1) * 1024 + ch) * 1024 + (q & 1) * 512 + l * 8);
            s += (bflo(v.x) - bfhi(v.x)) + (bflo(v.y) - bfhi(v.y)) + (bflo(v.z) - bfhi(v.z)) + (bflo(v.w) - bfhi(v.w)); }
        s = wave_sum(s);
        if (l == 0) Y[ch] = f2bf(s * 0.02209708691207961f * bflo((unsigned)FZ[ch]));
    }
}

DI void mixer_phase(const Params& p, LAS unsigned char* lds, int slot) {
    const int layer = slot & 1;
    unsigned* ctr = (unsigned*)(p.ws + WS_CTL) + 64 * slot;
    volatile LAS int* bc = (volatile LAS int*)(lds + LDS_RING);
    const int tid = threadIdx.x;
    for (;;) {
        __syncthreads();
        if (tid == 0) bc[0] = (int)atomicAdd(ctr, 1u);
        __syncthreads();
        const int u = bc[0];
        if (u >= 900) break;
        unsigned* sflag = (unsigned*)(p.ws + WS_CTL) + 768 + 16 * slot;
        if (u < 32) { ret_state_job(p, lds, layer, u >> 3, (u >> 1) & 3, u & 1, sflag + (u >> 1)); }
        else if (u < 96) {
            const int v = u - 32, part = v & 3, tile = v >> 2;
            pg8::Gemm g; OneUnit S; EpiDftHalf E;
            g.A = (const bf16_t*)(p.ws + WS_TABL) + (size_t)part * 1024 * 1024; g.Bt = (const bf16_t*)(p.ws + WS_UTL) + (size_t)part * 1024 * 1024; g.M = 1024; g.N = 1024; g.K = 1024;
            S.u.pm = tile & 3; S.u.pn = tile >> 2;
            E.FZ = (const bf16_t*)(p.ws + WS_FZ); E.Y = (bf16_t*)(p.ws + WS_H); E.PART = (bf16_t*)(p.ws + WS_PART); E.cnt = (unsigned*)(p.ws + WS_CTL) + 256 + 32 * slot; E.half = part;
            pg8::gemm_phase<EpiDftHalf, OneUnit, false, true>(lds, g, S, E);
        } else if (u < 100) { dft_nyquist_job(p, u - 96); }
        else if (u >= 484 && u < 516) {
            const int i = u - 484;
            pg8::Gemm g; OneUnit S; EpiDft E;
            E.FZ = (const bf16_t*)(p.ws + WS_FZ); E.Y = (bf16_t*)(p.ws + WS_H);
            g.A = (const bf16_t*)(p.ws + WS_TABC); g.Bt = (const bf16_t*)(p.ws + WS_UTC); g.M = 256; g.N = 8192; g.K = 512; S.u.pm = 0; S.u.pn = i; E.tokbase = 0; E.T = 256;
            pg8::gemm_phase<EpiDft, OneUnit, false, true>(lds, g, S, E);
        } else if (u < 356) { const int i = u - 100; attn_unit<true>(p, lds, layer, i >> 6, (i >> 5) & 1, i & 31); }
        else if (u < 484) { const int i = u - 356; ret_unit<false>(p, lds, layer, i >> 2, i & 3, 0, nullptr); }
        else if (u < 772) { const int i = u - 516; attn_unit<false>(p, lds, layer, i >> 3, (i >> 2) & 1, i & 3); }
        else { const int i = u - 772; ret_unit<true>(p, lds, layer, i >> 5, (i >> 3) & 3, i & 7, sflag + (i >> 3)); }
    }
}

#define RLX_AGENT __ATOMIC_RELAXED, __HIP_MEMORY_SCOPE_AGENT
#define XB_TMO      128
#define XB_XCNT(j)  (256  + 64 * (j))
#define XB_XSUB(j)  (1280 + 64 * (j))
#define XB_XGEN(j)  (2304 + 64 * (j))
#define XB_TOP      3328
#define XB_TOPGEN   3392
#define XCD_BAR_WORDS 3456
#define XB_SPIN_CAP (1u << 18)

__device__ __forceinline__ unsigned xb_ld(unsigned* p)              { return __hip_atomic_load(p, __ATOMIC_RELAXED, __HIP_MEMORY_SCOPE_AGENT); }
__device__ __forceinline__ unsigned xb_add(unsigned* p, unsigned v) { return __hip_atomic_fetch_add(p, v, __ATOMIC_RELAXED, __HIP_MEMORY_SCOPE_AGENT); }
__device__ __forceinline__ unsigned xb_xcc_id() { return (unsigned)__builtin_amdgcn_s_getreg((3 << 11) | 20) & 0xFu; }
#define XB_SPIN(cond, bar) do { unsigned _sp = 0; while (cond) { __builtin_amdgcn_s_sleep(1); \
    if ((++_sp & 255u) == 0u) { if (xb_ld(&(bar)[XB_TMO])) break; if (_sp > XB_SPIN_CAP) { atomicAdd(&(bar)[XB_TMO], 1u); break; } } } } while (0)

struct XcdBarrier {
    unsigned* bar; unsigned x;
    volatile LAS unsigned* st;
};

__device__ __forceinline__ XcdBarrier xcd_barrier_post(unsigned* bar, volatile LAS unsigned* st) {
    XcdBarrier b; b.bar = bar; b.x = xb_xcc_id(); b.st = st;
    if (threadIdx.x == 0) (void)xb_add(&bar[XB_XCNT(b.x)], 1u);
    return b;
}
__device__ __forceinline__ void xcd_barrier_complete(unsigned* bar, unsigned x, unsigned& nloc, unsigned& nx) {
    const unsigned G = gridDim.x * gridDim.y * gridDim.z;
    unsigned sum, cnt, mine, sp = 0u;
    for (;;) {
        sum = 0u; cnt = 0u; mine = 0u;
#pragma unroll
        for (unsigned j = 0; j < 16; ++j) { const unsigned c = xb_ld(&bar[XB_XCNT(j)]); sum += c; cnt += (c > 0u) ? 1u : 0u; mine = (j == x) ? c : mine; }
        if (sum == G) break;
        __builtin_amdgcn_s_sleep(1);
        if ((++sp & 255u) == 0u) { if (xb_ld(&bar[XB_TMO])) break; if (sp > XB_SPIN_CAP) { atomicAdd(&bar[XB_TMO], 1u); break; } }
    }
    nloc = mine > 0u ? mine : 1u; nx = cnt > 0u ? cnt : 1u;
}

__device__ __forceinline__ void xcd_barrier(const XcdBarrier& b) {
    asm volatile("s_waitcnt vmcnt(0)" ::: "memory");
    __syncthreads();
    if (threadIdx.x == 0) {
        unsigned* bar = b.bar;
        __builtin_amdgcn_s_waitcnt(0);
        unsigned nloc = b.st[0], nx = b.st[1];
        if (nloc == 0u) { xcd_barrier_complete(bar, b.x, nloc, nx); b.st[0] = nloc; b.st[1] = nx; }
        const unsigned old = xb_add(&bar[XB_XSUB(b.x)], 1u);
        const unsigned gen = old / nloc;
        if (old + 1u == (gen + 1u) * nloc) {
            __builtin_amdgcn_fence(__ATOMIC_RELEASE, "agent");
            asm volatile("s_waitcnt vmcnt(0)" ::: "memory");
            const unsigned og = xb_add(&bar[XB_TOP], 1u);
            const unsigned tg = og / nx;
            if (og + 1u == (tg + 1u) * nx) xb_add(&bar[XB_TOPGEN], 1u);
            else XB_SPIN(xb_ld(&bar[XB_TOPGEN]) == tg, bar);
            __builtin_amdgcn_fence(__ATOMIC_ACQUIRE, "agent");
            xb_add(&bar[XB_XGEN(b.x)], 1u);
            asm volatile("s_waitcnt vmcnt(0)" ::: "memory");
        } else {
            XB_SPIN(xb_ld(&bar[XB_XGEN(b.x)]) == gen, bar);
            __builtin_amdgcn_fence(__ATOMIC_ACQUIRE, "agent");
            asm volatile("s_waitcnt vmcnt(0)" ::: "memory");
        }
    }
    __syncthreads();
}

__global__ void __launch_bounds__(512, 2) fwd_kernel(Params p) {
    extern __shared__ __attribute__((aligned(16))) unsigned char lds_raw[];
    LAS unsigned char* lds = (LAS unsigned char*)lds_raw;
    cg::grid_group grid = cg::this_grid();
    const int lo = p.ph_lo, hi = p.ph_hi, G = gridDim.x;
#define IN(k) (lo <= (k) && (k) < hi)
#ifndef PHMASK
#define PHMASK 0x7f
#endif
#define PH_ON(k) ((PHMASK >> (k)) & 1)
#ifndef REPMASK
#define REPMASK 0
#endif
#define REP_ON(k) ((REPMASK >> (k)) & 1)
    { volatile LAS unsigned* z = (volatile LAS unsigned*)(lds + LDS_RING); if (threadIdx.x < 32) z[threadIdx.x] = 0u; }
    __syncthreads();
    XcdBarrier bar = xcd_barrier_post((unsigned*)(p.ws + WS_CTL) + 1024, (volatile LAS unsigned*)(lds + LDS_RING + 64));
    if (lo < 0) grid.sync();
#define SEAM(k) do { if (IN(k) && IN((k) + 1)) xcd_barrier(bar); } while (0)
#pragma unroll 1
    for (int rep = 0; rep < 1 + 2 * REP_ON(0); ++rep)
    if (PH_ON(0) && IN(0)) { phase0(p, lds); }
    SEAM(0);
#pragma unroll 1
    for (int l = 0; l < 2; ++l) {
        const int pb = 1 + 5 * l;
#pragma unroll 1
        for (int rep = 0; rep < 1 + REP_ON(1); ++rep)
        if (PH_ON(1) && IN(pb)) { if (l == 0) { weight_prep(p, lds, true, true); phase0b(p, lds); } row_pass(p, l); }
        SEAM(pb);
#pragma unroll 1
        for (int rep = 0; rep < 1 + REP_ON(2); ++rep)
        if (PH_ON(2) && IN(pb + 1)) {
            pg8::Gemm g{(const bf16_t*)(p.ws + WS_H), (const bf16_t*)(p.ws + WS_WINT + wl(l)), NTOK, NWIN, DM}; pg8::StaticOrder S; S.init(NTOK, NWIN, G, (int)blockIdx.x);
            EpiIn E{p.ws, p.out, (const float*)(p.ws + WS_LG2), l, lds + LDS_STAGE};
            pg8::gemm_phase<EpiIn, pg8::StaticOrder, true, true>(lds, g, S, E);
        }
        SEAM(pb + 1);
#pragma unroll 1
        for (int rep = 0; rep < 1 + REP_ON(3); ++rep)
        if (PH_ON(3) && IN(pb + 2)) mixer_phase(p, lds, l + 2 * rep);
        SEAM(pb + 2);
#pragma unroll 1
        for (int rep = 0; rep < 1 + REP_ON(4); ++rep)
        if (PH_ON(4) && IN(pb + 3)) {
            pg8::Gemm g{(const bf16_t*)(p.ws + WS_H), (const bf16_t*)(p.ws + WS_WBRT + wl(l)), NTOK, DM, DM}; pg8::StaticOrder S; S.init(NTOK, DM, G, (int)blockIdx.x);
            EpiMerge E{p.ws + WS_MG8, (bf16_t*)(p.ws + WS_MERGED)};
            pg8::gemm_phase<EpiMerge, pg8::StaticOrder, false, true>(lds, g, S, E);
        }
        SEAM(pb + 3);
#pragma unroll 1
        for (int rep = 0; rep < 1 + REP_ON(5); ++rep)
        if (PH_ON(5) && IN(pb + 4)) {
            pg8::Gemm g{(const bf16_t*)(p.ws + WS_MERGED), (const bf16_t*)(p.ws + WS_WOUTT + wl(l)), NTOK, DM, DM}; pg8::StaticOrder S; S.init(NTOK, DM, G, (int)blockIdx.x);
            EpiOut E{(bf16_t*)(p.ws + WS_OUT)};
            pg8::gemm_phase<EpiOut, pg8::StaticOrder, false, true>(lds, g, S, E);
        }
        SEAM(pb + 4);
#pragma unroll 1
        for (int rep = 0; rep < 5 * REP_ON(7); ++rep) xcd_barrier(bar);
    }
    if (PH_ON(6) && IN(11)) row_pass(p, 2);
#undef IN
#undef SEAM
}

extern "C" void kernel_launch(void* const* d_in, const int* in_sizes, int n_in, void* d_out, int out_size, void* d_ws, size_t ws_size, hipStream_t stream) {
    static int grid = 0;
    if (grid == 0) {
        int dev = 0, cus = 0, per_cu = 0;
        if (n_in != 20 || ws_size < WS_END) { fprintf(stderr, "kernel_launch: unexpected inputs (n_in %d, ws %zu)\n", n_in, ws_size); grid = -1; return; }
        hipGetDevice(&dev);
        hipDeviceGetAttribute(&cus, hipDeviceAttributeMultiprocessorCount, dev);
        if (hipFuncSetAttribute((const void*)fwd_kernel, hipFuncAttributeMaxDynamicSharedMemorySize, LDS_BYTES) != hipSuccess) { fprintf(stderr, "kernel_launch: hipFuncSetAttribute failed\n"); grid = -1; return; }
        if (hipOccupancyMaxActiveBlocksPerMultiprocessor(&per_cu, (const void*)fwd_kernel, 512, LDS_BYTES) != hipSuccess || per_cu < 1) { fprintf(stderr, "kernel_launch: occupancy query says %d\n", per_cu); per_cu = 1; }
        (void)hipGetLastError();
        grid = cus * per_cu;
    }
    if (grid < 0) return;
    hipMemsetAsync((char*)d_ws + WS_CTL, 0, CTL_BYTES, stream);
    Params p{};
    const float** f = (const float**)&p;
    for (int i = 0; i < 20; ++i) f[i] = (const float*)d_in[i];
    p.out = (float*)d_out; p.ws = (unsigned char*)d_ws; p.ph_lo = 0; p.ph_hi = 12;
    void* args[] = {&p};
    const hipError_t e = hipLaunchCooperativeKernel((const void*)fwd_kernel, dim3(grid), dim3(512), args, LDS_BYTES, stream);
    if (e != hipSuccess) fprintf(stderr, "kernel_launch: cooperative launch failed: %s (grid %d)\n", hipGetErrorString(e), grid);
}
```

```cpp
#include <hip/hip_runtime.h>
#include <hip/hip_cooperative_groups.h>
#include <cstdio>
#include <cstdint>
namespace cg = cooperative_groups;

namespace pg8 {
#define PG8_LAS __attribute__((address_space(3)))
typedef unsigned short bf16_t;
typedef short bf16x8 __attribute__((ext_vector_type(8)));
typedef float f32x4 __attribute__((ext_vector_type(4)));
typedef unsigned u32x4 __attribute__((ext_vector_type(4)));
constexpr int BM = 256, BK = 64, HALF = 128, HTB = HALF * BK * 2  , STAGE_BYTES = 8 * HTB, NXCD = 8, WGM = 8;

__host__ __device__ __forceinline__ int lds_byte(int r, int c) { const int st = (r >> 4) * 2 + (c >> 5), rr = r & 15, cc = c & 31, ob = rr * 64 + cc * 2; return st * 1024 + (ob ^ (((ob >> 9) & 1) << 5)); }
__host__ __device__ __forceinline__ void stage_rc(int b, int& R, int& C) { const int st = b / 1024, sb = b % 1024, swz = sb ^ (((sb >> 9) & 1) << 5); R = (st >> 1) * 16 + swz / 64; C = (st & 1) * 32 + (swz % 64) / 2; }
__host__ __device__ __forceinline__ int perm32(int rho) { const int n = rho >> 4, i = rho & 15; return 8 * (i >> 2) + 4 * n + (i & 3); }

struct Unit { int pm, pn; };
struct Gemm { const bf16_t* A; const bf16_t* Bt; int M, N, K; };

struct StaticOrder {
    int nM, nN, nwg, G, c;
    __host__ __device__ void init(int M, int N, int G_, int c_) { nM = M / BM; nN = N / BM; nwg = nM * nN; G = G_; c = c_; }
    __host__ __device__ bool next(int i, Unit& u) const {
        const long L = (long)i * G + c; if (L >= nwg) return false;
        int wgid = (int)L; { const int q = nwg / NXCD, r = nwg % NXCD, xcd = wgid % NXCD, off = wgid / NXCD; wgid = (xcd < r ? xcd * (q + 1) : r * (q + 1) + (xcd - r) * q) + off; }
        const int nig = WGM * nN, gid = wgid / nig, fm = gid * WGM, gsz = (nM - fm) < WGM ? (nM - fm) : WGM;
        u.pm = fm + ((wgid % nig) % gsz); u.pn = (wgid % nig) / gsz; return true;
    }
    __device__ __forceinline__ void a_ready(const Unit&) const {}
    __device__ __forceinline__ void done(const Unit&) const {}
};
__device__ __forceinline__ unsigned cvt_pk_bf16(float lo, float hi) { unsigned r; asm volatile("v_cvt_pk_bf16_f32 %0, %1, %2" : "=v"(r) : "v"(lo), "v"(hi)); return r; }
template <class Epi, class Sched, bool ALIGN_EPI = false, bool SP2 = false>
__device__ __forceinline__ void gemm_phase(PG8_LAS unsigned char* lds, const Gemm g, const Sched& S, const Epi& E) {
    int tid_l = threadIdx.x; asm volatile("" : "+v"(tid_l));
    const int tid = tid_l, wid = __builtin_amdgcn_readfirstlane(tid >> 6), lane = tid & 63, wr = wid >> 2, wc = wid & 3, fr = lane & 15, fq = lane >> 4;
    const int K = g.K, nt = K / BK;
    unsigned voffA[2], voffB[2];
#pragma unroll
    for (int i = 0; i < 2; ++i) { int R, C; stage_rc(tid * 16 + i * 8192, R, C); const int Rb = Epi::PERM ? ((R & ~31) + perm32(R & 31)) : R;
        voffA[i] = (unsigned)(R * K + C) * 2u; voffB[i] = (unsigned)(Rb * K + C) * 2u; }
    const size_t kstep = (size_t)(BK * 2);
    const size_t hstep = (size_t)HALF * K * 2;
    const size_t tstep = 2 * hstep;
    const unsigned ldsw = (unsigned)wid * 1024u;
    const int aoff = lds_byte(wr * 64 + fr, fq * 8), boff = lds_byte(wc * 32 + fr, fq * 8);
#define PG8_SA(b, h) (((b) * 2 + (h)) * HTB)
#define PG8_SB(b, h) ((4 + (b) * 2 + (h)) * HTB)
#define PG8_STAGE(bufoff, gbase, voff) do { _Pragma("unroll") for (int _i = 0; _i < 2; ++_i) \
        __builtin_amdgcn_global_load_lds((const unsigned*)((const char*)(gbase) + (voff)[_i]), (PG8_LAS unsigned*)(lds + (bufoff) + ldsw + _i * 8192), 16, 0, 0); } while (0)
#define PG8_LDA(dst, b, h) do { _Pragma("unroll") for (int m = 0; m < 4; ++m) _Pragma("unroll") for (int k = 0; k < 2; ++k) dst[m][k] = *(const PG8_LAS bf16x8*)(lds + PG8_SA(b, h) + aoff + m * 2048 + k * 1024); } while (0)
#define PG8_LDB(dst, b, h) do { _Pragma("unroll") for (int n = 0; n < 2; ++n) _Pragma("unroll") for (int k = 0; k < 2; ++k) dst[n][k] = *(const PG8_LAS bf16x8*)(lds + PG8_SB(b, h) + boff + n * 2048 + k * 1024); } while (0)
#define PG8_MMA(ai, bj, At, Bt) do { __builtin_amdgcn_s_setprio(1); _Pragma("unroll") for (int m = 0; m < 4; ++m) _Pragma("unroll") for (int n = 0; n < 2; ++n) _Pragma("unroll") for (int k = 0; k < 2; ++k) \
        acc[ai][bj][m][n] = __builtin_amdgcn_mfma_f32_16x16x32_bf16(Bt[n][k], At[m][k], acc[ai][bj][m][n], 0, 0, 0); __builtin_amdgcn_s_setprio(0); } while (0)
#define PG8_WAIT_V(n) asm volatile("s_waitcnt vmcnt(" #n ")" ::: "memory")
#define PG8_WAIT_L(n) asm volatile("s_waitcnt lgkmcnt(" #n ")" ::: "memory")
#define PG8_BAR __builtin_amdgcn_s_barrier()
#define PG8_SCHED __builtin_amdgcn_sched_barrier(0)
    Unit cur, nxt; int ui = 0;
    if (!S.next(0, cur)) return;
    f32x4 acc[2][2][4][2];
#pragma unroll
    for (int a = 0; a < 2; ++a)
#pragma unroll
        for (int b = 0; b < 2; ++b)
#pragma unroll
            for (int m = 0; m < 4; ++m)
#pragma unroll
                for (int n = 0; n < 2; ++n) acc[a][b][m][n] = (f32x4){0.f, 0.f, 0.f, 0.f};
    bf16x8 At[4][2], B0[2][2], B1[2][2];
    const char* cA = (const char*)g.A + (size_t)cur.pm * tstep; const char* cB = (const char*)g.Bt + (size_t)cur.pn * tstep;
    S.a_ready(cur);
    if constexpr (SP2) {
        PG8_STAGE(PG8_SB(0, 0), cB, voffB); PG8_STAGE(PG8_SB(0, 1), cB + hstep, voffB); PG8_STAGE(PG8_SA(0, 0), cA, voffA); PG8_STAGE(PG8_SA(0, 1), cA + hstep, voffA);
        if (wr == 1) PG8_BAR;
        PG8_WAIT_V(2); PG8_BAR;
        PG8_STAGE(PG8_SB(1, 0), cB + kstep, voffB); PG8_STAGE(PG8_SA(1, 0), cA + kstep, voffA); PG8_STAGE(PG8_SB(1, 1), cB + hstep + kstep, voffB);
        PG8_WAIT_V(6); PG8_BAR;
    } else {
        PG8_STAGE(PG8_SB(0, 0), cB, voffB); PG8_STAGE(PG8_SA(0, 0), cA, voffA); PG8_STAGE(PG8_SB(0, 1), cB + hstep, voffB); PG8_STAGE(PG8_SA(0, 1), cA + hstep, voffA);
        if (wr == 1) PG8_BAR;
        PG8_WAIT_V(4); PG8_BAR;
        PG8_STAGE(PG8_SB(1, 0), cB + kstep, voffB); PG8_STAGE(PG8_SA(1, 0), cA + kstep, voffA); PG8_STAGE(PG8_SB(1, 1), cB + hstep + kstep, voffB);
        PG8_WAIT_V(6); PG8_BAR;
    }
    for (;;) {
        const bool has_next = S.next(ui + 1, nxt);
        const char* nA = has_next ? (const char*)g.A + (size_t)nxt.pm * tstep : cA; const char* nB = has_next ? (const char*)g.Bt + (size_t)nxt.pn * tstep : cB;
        for (int t = 0; t < nt; t += 2) {
            if constexpr (Epi::HOOK) { if (t == 4 || t == 8) E.seg(acc, cur, t, wr, wc, fr, fq); }
            const bool last = (t == nt - 2);
            const char* a1 = cA + (size_t)(t + 1) * kstep;
            const char* a2 = last ? nA : cA + (size_t)(t + 2) * kstep; const char* b2 = last ? nB : cB + (size_t)(t + 2) * kstep;
            const char* a3 = a2 + kstep; const char* b3 = b2 + kstep;
            if (last && has_next) S.a_ready(nxt);
            if constexpr (SP2) {
            PG8_LDB(B0, 0, 0); PG8_LDB(B1, 0, 1); PG8_SCHED; PG8_LDA(At, 0, 0); PG8_STAGE(PG8_SA(1, 1), a1 + hstep, voffA);
            PG8_WAIT_V(8); PG8_WAIT_L(0); PG8_BAR; PG8_MMA(0, 0, At, B0); PG8_MMA(0, 1, At, B1); PG8_BAR; PG8_SCHED;
            PG8_LDA(At, 0, 1); PG8_STAGE(PG8_SB(0, 0), b2, voffB); PG8_STAGE(PG8_SB(0, 1), b2 + hstep, voffB); PG8_STAGE(PG8_SA(0, 0), a2, voffA);
            PG8_WAIT_V(8); PG8_WAIT_L(0); PG8_BAR; PG8_MMA(1, 0, At, B0); PG8_MMA(1, 1, At, B1); PG8_BAR; PG8_SCHED;
            PG8_LDB(B0, 1, 0); PG8_LDB(B1, 1, 1); PG8_SCHED; PG8_LDA(At, 1, 0); PG8_STAGE(PG8_SA(0, 1), a2 + hstep, voffA);
            PG8_WAIT_V(8); PG8_WAIT_L(0); PG8_BAR; PG8_MMA(0, 0, At, B0); PG8_MMA(0, 1, At, B1); PG8_BAR; PG8_SCHED;
            PG8_LDA(At, 1, 1); PG8_STAGE(PG8_SB(1, 0), b3, voffB); PG8_STAGE(PG8_SB(1, 1), b3 + hstep, voffB); PG8_STAGE(PG8_SA(1, 0), a3, voffA);
            PG8_WAIT_V(8); PG8_WAIT_L(0); PG8_BAR; PG8_MMA(1, 0, At, B0); PG8_MMA(1, 1, At, B1); PG8_BAR; PG8_SCHED;
            } else {
            PG8_LDB(B0, 0, 0); PG8_SCHED; PG8_LDA(At, 0, 0); PG8_STAGE(PG8_SA(1, 1), a1 + hstep, voffA);
            PG8_WAIT_L(8); PG8_BAR; PG8_WAIT_L(0); PG8_MMA(0, 0, At, B0); PG8_BAR; PG8_SCHED;
            PG8_LDB(B1, 0, 1); PG8_STAGE(PG8_SB(0, 0), b2, voffB);
            PG8_BAR; PG8_WAIT_L(0); PG8_MMA(0, 1, At, B1); PG8_BAR;
            PG8_LDA(At, 0, 1); PG8_STAGE(PG8_SA(0, 0), a2, voffA);
            PG8_BAR; PG8_WAIT_L(0); PG8_MMA(1, 0, At, B0); PG8_BAR; PG8_SCHED;
            PG8_STAGE(PG8_SB(0, 1), b2 + hstep, voffB);
            PG8_WAIT_V(6); PG8_BAR; PG8_MMA(1, 1, At, B1); PG8_BAR;
            PG8_LDB(B0, 1, 0); PG8_SCHED; PG8_LDA(At, 1, 0); PG8_STAGE(PG8_SA(0, 1), a2 + hstep, voffA);
            PG8_WAIT_L(8); PG8_BAR; PG8_WAIT_L(0); PG8_MMA(0, 0, At, B0); PG8_BAR; PG8_SCHED;
            PG8_LDB(B1, 1, 1); PG8_STAGE(PG8_SB(1, 0), b3, voffB);
            PG8_BAR; PG8_WAIT_L(0); PG8_MMA(0, 1, At, B1); PG8_BAR;
            PG8_LDA(At, 1, 1); PG8_STAGE(PG8_SA(1, 0), a3, voffA);
            PG8_BAR; PG8_WAIT_L(0); PG8_MMA(1, 0, At, B0); PG8_BAR; PG8_SCHED;
            PG8_STAGE(PG8_SB(1, 1), b3 + hstep, voffB);
            PG8_WAIT_V(6); PG8_BAR; PG8_MMA(1, 1, At, B1); PG8_BAR;
            }
        }
        if constexpr (ALIGN_EPI) { if (wr == 0) PG8_BAR; }
        if constexpr (!Epi::AFTER_DRAIN) { E(acc, cur, wr, wc, fr, fq); S.done(cur); }
        if (!has_next) break;
#pragma unroll
        for (int a = 0; a < 2; ++a)
#pragma unroll
            for (int b = 0; b < 2; ++b)
#pragma unroll
                for (int m = 0; m < 4; ++m)
#pragma unroll
                    for (int n = 0; n < 2; ++n) acc[a][b][m][n] = (f32x4){0.f, 0.f, 0.f, 0.f};
        cur = nxt; cA = nA; cB = nB; ++ui;
        if constexpr (ALIGN_EPI) { if (wr == 1) PG8_BAR; }
    }
    PG8_WAIT_V(0);
    if constexpr (!ALIGN_EPI) { if (wr == 0) PG8_BAR; }
    PG8_BAR;
    if constexpr (Epi::AFTER_DRAIN) { E.fused(acc, cur, wr, wc, fr, fq, lds, wid, lane); S.done(cur); }
#undef PG8_SA
#undef PG8_SB
#undef PG8_STAGE
#undef PG8_LDA
#undef PG8_LDB
#undef PG8_MMA
#undef PG8_WAIT_V
#undef PG8_WAIT_L
#undef PG8_BAR
#undef PG8_SCHED
}
}

#define DI __device__ __forceinline__
#define LAS __attribute__((address_space(3)))
using pg8::bf16_t; using pg8::bf16x8; using pg8::f32x4; using pg8::Unit;
typedef float f32x16 __attribute__((ext_vector_type(16)));
typedef unsigned u32x4 __attribute__((ext_vector_type(4)));
typedef unsigned u32x2 __attribute__((ext_vector_type(2)));
typedef float f32x2_t __attribute__((ext_vector_type(2)));
typedef __bf16 bf16x2_t __attribute__((ext_vector_type(2)));

constexpr int NTOK = 16384, NCTX = 8192, DM = 1024, NWIN = 6144, WIN_LD = 5888;
constexpr float LOG2E = 1.4426950408889634f;
constexpr float EPS = 1e-6f;
constexpr size_t MiB = 1u << 20;
constexpr size_t WS_CTL = 0, CTL_BYTES = 32768;
constexpr size_t WS_MOD = 1 * MiB;
constexpr size_t WS_LG2 = WS_MOD + 128 * 1024;
constexpr size_t WS_ROPE = WS_LG2 + 256;
constexpr size_t WS_IDENT = WS_ROPE + 8192;
constexpr size_t WS_W4 = 2 * MiB;
constexpr size_t WS_TABC = 3 * MiB;
constexpr size_t WS_CKB = 3 * MiB + 512 * 1024;
constexpr size_t WS_CVT = WS_CKB + 1 * MiB;
constexpr size_t WS_S0T = WS_CVT + 1 * MiB;
constexpr size_t WS_TABL = 6 * MiB;
constexpr size_t WS_WINT = 22 * MiB;
constexpr size_t WS_WBRT = 34 * MiB;
constexpr size_t WS_WOUTT = 36 * MiB;
constexpr size_t WS_H = 38 * MiB;
constexpr size_t WS_UTC = 70 * MiB, WS_UTL = 78 * MiB, WS_FZ = 86 * MiB, WS_RQ = 94 * MiB, WS_RK = 102 * MiB, WS_RVT = 110 * MiB, WS_RZ = 118 * MiB,
                 WS_AQ = 126 * MiB, WS_AK = 142 * MiB, WS_AVT = 146 * MiB, WS_AZ = 150 * MiB, WS_RKTF = 166 * MiB, WS_RKTB = 170 * MiB, WS_MG8 = 174 * MiB, WS_PART = 222 * MiB, WS_RKTFL = 230 * MiB, WS_RKTBL = 234 * MiB, WS_W2 = 238 * MiB, WS_SCH = 254 * MiB, WS_END = 256 * MiB;
constexpr size_t WS_MERGED = 70 * MiB;
constexpr size_t WS_OUT = 102 * MiB;
DI size_t wl(int l) { return l ? (WS_W2 - WS_WINT) : 0; }
constexpr size_t O_Y = 0, O_CK = 16777216, O_CV = 18874368, O_ST = 20971520;
constexpr int LDS_RING = 131072, LDS_STAGE = LDS_RING + 256, STAGE_WAVE = 2560, LDS_BYTES = LDS_STAGE + 8 * STAGE_WAVE;

struct Params {
    const float *x_prompt, *x_sample, *cache_k, *cache_v, *state_ret, *c, *c_ctx, *w_mod, *b_mod, *g_pre, *g_post, *w_in, *w_four, *ret_decay, *ret_gn, *attn_sink,
                *w_pa, *w_pb, *w_pc, *w_out;
    float* out; unsigned char* ws; int ph_lo, ph_hi;
};

DI unsigned pk2(float lo, float hi) { f32x2_t v = {lo, hi}; bf16x2_t b = __builtin_convertvector(v, bf16x2_t); return __builtin_bit_cast(unsigned, b); }
DI bf16_t f2bf(float x) { return (bf16_t)(pk2(x, 0.f) & 0xffffu); }
DI float bflo(unsigned u) { return __uint_as_float(u << 16); }
DI float bfhi(unsigned u) { return __uint_as_float(u & 0xffff0000u); }
DI float silu_f(float v) { return v * __builtin_amdgcn_rcpf(1.f + __expf(-v)); }
DI float sigm_f(float v) { return __builtin_amdgcn_rcpf(1.f + __expf(-v)); }
DI float wave_sum(float v) {
#pragma unroll
    for (int o = 1; o < 64; o <<= 1) v += __shfl_xor(v, o);
    return v;
}
#define LDS_WAIT() asm volatile("s_waitcnt lgkmcnt(0)" ::: "memory")
#define MFMA32(a, b, c) __builtin_amdgcn_mfma_f32_32x32x16_bf16((a), (b), (c), 0, 0, 0)
DI int crow(int reg, int h) { return (reg & 3) + 8 * (reg >> 2) + 4 * h; }

DI size_t fragmajor(int bh, int r, int t) { const size_t blk = (size_t)(bh * 2 + (r >> 5)) * 8 + (t >> 8); const size_t step = blk * 16 + ((t & 255) >> 4); const size_t lane = step * 64 + ((t >> 3) & 1) * 32 + (r & 31); return lane * 8 + (t & 7); }
DI int colperm(int blk) { return (blk >= 2 && blk <= 5) ? (blk ^ 6) : blk; }
struct EpiIn {
    static constexpr bool PERM = true, AFTER_DRAIN = false, HOOK = false;
    unsigned char* ws; float* out; const float* lg2; int layer; LAS unsigned char* stage;
    DI void rope8(float (&v)[8], int t, int wc, int fq) const {
        const float* rc = (const float*)(ws + WS_ROPE); const float* rs = rc + 1024;
        const int pos = (wc & 1) ? (t & 63) : (t >> 6);
        const int i0 = 8 * (fq & 1);
        const f32x4 c_lo = *(const f32x4*)(rc + pos * 16 + i0), c_hi = *(const f32x4*)(rc + pos * 16 + i0 + 4);
        const f32x4 s_lo = *(const f32x4*)(rs + pos * 16 + i0), s_hi = *(const f32x4*)(rs + pos * 16 + i0 + 4);
        const bool second = (fq >> 1) != 0;
#pragma unroll
        for (int e = 0; e < 8; ++e) {
            const float pv = __shfl_xor(v[e], 32);
            const float cs = e < 4 ? c_lo[e & 3] : c_hi[e & 3], sn = e < 4 ? s_lo[e & 3] : s_hi[e & 3];
            v[e] = v[e] * cs + (second ? pv : -pv) * sn;
        }
    }
    DI void tstore(const float (&va)[8], const float (&vb)[8], int fr, int fq, int wid, bf16_t* g, size_t chs) const {
        LAS unsigned char* st = stage + wid * STAGE_WAVE;
#pragma unroll
        for (int e = 0; e < 8; ++e) { *(LAS bf16_t*)(st + (8 * fq + e) * 80 + fr * 2) = f2bf(va[e]); *(LAS bf16_t*)(st + (8 * fq + e) * 80 + (16 + fr) * 2) = f2bf(vb[e]); }
        LDS_WAIT();
        const int lane = fq * 16 + fr;
#pragma unroll
        for (int k = 0; k < 2; ++k) { const int pc = lane + 64 * k, ch = pc >> 2, tp = pc & 3;
            const u32x4 w = *(const LAS u32x4*)(st + ch * 80 + tp * 16);
            *(u32x4*)(g + (size_t)ch * chs + tp * 8) = w; }
        LDS_WAIT();
    }
    template <int BJ, int TYPE, bool LATT>
    DI void tile(const f32x4 (&acc)[2][2][4][2], const Unit& u, int wr, int wc, int fr, int fq) const {
        constexpr int T = LATT ? 2048 : 256;
        const int cb = colperm(u.pn) * 256 + BJ * 128, c0 = cb + wc * 32 + 8 * fq;
        const float* rc = (const float*)(ws + WS_ROPE); const float* rs = rc + 1024;
        if (TYPE == 0 || TYPE == 4 || TYPE == 8 || TYPE == 3) {
            const int wid = wr * 4 + wc;
            const int bq = LATT ? (u.pm - 32) >> 3 : u.pm, tq = LATT ? ((u.pm - 32) & 7) * 256 : 0;
#pragma unroll
            for (int ai = 0; ai < 2; ++ai)
#pragma unroll
                for (int mp = 0; mp < 2; ++mp) {
                    int t0 = tq + ai * 128 + wr * 64 + mp * 32; asm volatile("" : "+s"(t0));
                    float va[8], vb[8];
#pragma unroll
                    for (int e = 0; e < 8; ++e) { va[e] = acc[ai][BJ][2 * mp][e >> 2][e & 3]; vb[e] = acc[ai][BJ][2 * mp + 1][e >> 2][e & 3]; }
                    if (TYPE == 0) {
                        const int seg = cb >= 256 ? 1 : 0, ch0 = cb - seg * 256 + wc * 32;
                        bf16_t* g = LATT ? (bf16_t*)(ws + WS_UTL) + ((size_t)((seg * 2 + (t0 >> 10)) * 1024 + bq * 256 + ch0) * 1024 + (t0 & 1023))
                                         : (bf16_t*)(ws + WS_UTC) + ((size_t)(bq * 256 + ch0) * 512 + seg * 256 + t0);
                        tstore(va, vb, fr, fq, wid, g, LATT ? 1024 : 512);
                    } else if (TYPE == 4) {
                        const int cc0 = cb - 1280 + wc * 32;
                        tstore(va, vb, fr, fq, wid, (bf16_t*)(ws + WS_RVT) + (LATT ? (size_t)2 * 1024 * 1024 : 0) + ((size_t)(bq * 256 + cc0) * T + t0), T);
                    } else if (TYPE == 8) {
                        const int cc0 = cb - 2432 + wc * 32;
                        tstore(va, vb, fr, fq, wid, (bf16_t*)(ws + WS_AVT) + (LATT ? (size_t)1024 * 1024 : 0) + ((size_t)(bq * 128 + cc0) * T + t0), T);
                    } else {
                        const int cc0 = cb - 1024 + wc * 32, hd = cc0 >> 6;
                        const float lf = lg2[layer * 8 + hd], lb = lg2[layer * 8 + 4 + hd];
                        if (LATT) {
                            rope8(va, t0 + fr, wc, fq); rope8(vb, t0 + 16 + fr, wc, fq);
                            bf16_t* d0 = (bf16_t*)(ws + WS_RK) + (size_t)(NCTX + bq * 2048 + t0 + fr) * 256 + cc0 + 8 * fq;
                            u32x4 w; w.x = pk2(va[0] * 0.125f, va[1] * 0.125f); w.y = pk2(va[2] * 0.125f, va[3] * 0.125f); w.z = pk2(va[4] * 0.125f, va[5] * 0.125f); w.w = pk2(va[6] * 0.125f, va[7] * 0.125f);
                            *(u32x4*)d0 = w;
                            w.x = pk2(vb[0] * 0.125f, vb[1] * 0.125f); w.y = pk2(vb[2] * 0.125f, vb[3] * 0.125f); w.z = pk2(vb[4] * 0.125f, vb[5] * 0.125f); w.w = pk2(vb[6] * 0.125f, vb[7] * 0.125f);
                            *(u32x4*)(d0 + 16 * 256) = w;
                        }
                        const float ta = (float)((t0 & 255) + fr), tb = ta + 16.f;
                        const float wfa = 0.125f * __builtin_amdgcn_exp2f((255.f - ta) * lf), wfb = 0.125f * __builtin_amdgcn_exp2f((255.f - tb) * lf);
                        const float ra = __builtin_amdgcn_exp2f(ta * lb - (255.f - ta) * lf), rb = __builtin_amdgcn_exp2f(tb * lb - (255.f - tb) * lf);
#pragma unroll
                        for (int e = 0; e < 8; ++e) { va[e] *= wfa; vb[e] *= wfb; }
                        tstore(va, vb, fr, fq, wid, (bf16_t*)(ws + (LATT ? WS_RKTFL : WS_RKTF)) + ((size_t)(bq * 256 + cc0) * T + t0), T);
#pragma unroll
                        for (int e = 0; e < 8; ++e) { va[e] *= ra; vb[e] *= rb; }
                        tstore(va, vb, fr, fq, wid, (bf16_t*)(ws + (LATT ? WS_RKTBL : WS_RKTB)) + ((size_t)(bq * 256 + cc0) * T + t0), T);
                    }
                    asm volatile("" ::: "memory");
                }
        }
        if (TYPE != 0 && TYPE != 4 && !(TYPE == 3 && LATT))
#pragma unroll
        for (int ai = 0; ai < 2; ++ai)
#pragma unroll
            for (int m = 0; m < 4; ++m) {
                int row = u.pm * 256 + ai * 128 + wr * 64 + m * 16 + fr;
                asm volatile("" : "+v"(row));
                int b, t;
                if (LATT) { const int r2 = row - NCTX; b = r2 >> 11; t = r2 & 2047; } else { b = row >> 8; t = row & 255; }
                float v[8];
#pragma unroll
                for (int e = 0; e < 8; ++e) v[e] = acc[ai][BJ][m][e >> 2][e & 3];
                if (LATT && (TYPE == 2 || TYPE == 6 || TYPE == 7)) rope8(v, t, wc, fq);
                if (TYPE == 0) {
                    const int seg = cb >= 256 ? 1 : 0, ch = c0 - seg * 256;
                    bf16_t* dst = LATT ? (bf16_t*)(ws + WS_UTL) + ((size_t)seg * 4 * 256 * 2048 + (size_t)(b * 256 + ch) * 2048 + t)
                                       : (bf16_t*)(ws + WS_UTC) + ((size_t)(b * 256 + ch) * 512 + seg * 256 + t);
#pragma unroll
                    for (int e = 0; e < 8; ++e) dst[(size_t)e * (LATT ? 2048 : 512)] = f2bf(v[e]);
                } else if (TYPE == 1 || TYPE == 5 || TYPE == 9) {
                    bf16_t* dst = TYPE == 1 ? (bf16_t*)(ws + WS_FZ) + (size_t)row * 256 + (c0 - 512) : TYPE == 5 ? (bf16_t*)(ws + WS_RZ) + (size_t)row * 256 + (c0 - 1536)
                                                                                                                  : (bf16_t*)(ws + WS_AZ) + (size_t)row * 512 + (c0 - 2560);
                    u32x4 w; w.x = pk2(silu_f(v[0]), silu_f(v[1])); w.y = pk2(silu_f(v[2]), silu_f(v[3])); w.z = pk2(silu_f(v[4]), silu_f(v[5])); w.w = pk2(silu_f(v[6]), silu_f(v[7]));
                    *(u32x4*)dst = w;
                } else if (TYPE == 2) {
                    bf16_t* dst = (bf16_t*)(ws + WS_RQ) + (size_t)row * 256 + (c0 - 768);
                    u32x4 w; w.x = pk2(v[0], v[1]); w.y = pk2(v[2], v[3]); w.z = pk2(v[4], v[5]); w.w = pk2(v[6], v[7]);
                    *(u32x4*)dst = w;
                } else if (TYPE == 3) {
                    const int cc = c0 - 1024;
#pragma unroll
                    for (int e = 0; e < 8; ++e) v[e] *= 0.125f;
                    bf16_t* dst = (bf16_t*)(ws + WS_RK) + (size_t)row * 256 + cc;
                    u32x4 w; w.x = pk2(v[0], v[1]); w.y = pk2(v[2], v[3]); w.z = pk2(v[4], v[5]); w.w = pk2(v[6], v[7]);
                    *(u32x4*)dst = w;
                } else if (TYPE == 4) {
                    const int cc = c0 - 1280;
                    bf16_t* dst = (bf16_t*)(ws + WS_RVT) + (LATT ? (size_t)2 * 1024 * 1024 : 0) + ((size_t)(b * 256 + cc) * T + t);
#pragma unroll
                    for (int e = 0; e < 8; ++e) dst[(size_t)e * T] = f2bf(v[e]);
                } else if (TYPE == 6) {
                    bf16_t* dst = (bf16_t*)(ws + WS_AQ) + (size_t)row * 512 + (c0 - 1792);
                    u32x4 w; constexpr float QS = 0.125f * LOG2E; w.x = pk2(v[0] * QS, v[1] * QS); w.y = pk2(v[2] * QS, v[3] * QS); w.z = pk2(v[4] * QS, v[5] * QS); w.w = pk2(v[6] * QS, v[7] * QS);
                    *(u32x4*)dst = w;
                } else if (TYPE == 7) {
                    const int cc = c0 - 2304;
                    bf16_t* dst = (bf16_t*)(ws + WS_AK) + (size_t)row * 128 + cc;
                    u32x4 w; w.x = pk2(v[0], v[1]); w.y = pk2(v[2], v[3]); w.z = pk2(v[4], v[5]); w.w = pk2(v[6], v[7]);
                    *(u32x4*)dst = w;
                    if (!LATT) { float* o = out + O_CK + ((size_t)((b * 2 + layer) * 256 + t) * 128 + cc);
                        *(f32x4*)o = (f32x4){v[0], v[1], v[2], v[3]}; *(f32x4*)(o + 4) = (f32x4){v[4], v[5], v[6], v[7]}; }
                } else if (TYPE == 8) {
                    const int cc = c0 - 2432;
                    if (!LATT) { float* o = out + O_CV + ((size_t)((b * 2 + layer) * 256 + t) * 128 + cc);
                        *(f32x4*)o = (f32x4){v[0], v[1], v[2], v[3]}; *(f32x4*)(o + 4) = (f32x4){v[4], v[5], v[6], v[7]}; }
                } else {
                    unsigned q[8];
#pragma unroll
                    for (int e = 0; e < 8; ++e) { float g = rintf(sigm_f(v[e]) * 255.f); g = fminf(fmaxf(g, 1.f), 255.f); q[e] = (unsigned)g; }
                    u32x2 w; w.x = q[0] | (q[1] << 8) | (q[2] << 16) | (q[3] << 24); w.y = q[4] | (q[5] << 8) | (q[6] << 16) | (q[7] << 24);
                    *(u32x2*)(ws + WS_MG8 + (size_t)row * 3072 + (c0 - 3072)) = w;
                }
                asm volatile("" ::: "memory");
            }
    }
    template <int BJ, bool LATT>
    DI void tile_bj(const f32x4 (&acc)[2][2][4][2], const Unit& u, int wr, int wc, int fr, int fq) const {
        const int cb = colperm(u.pn) * 256 + BJ * 128;
        if (cb >= 3072) tile<BJ, 10, LATT>(acc, u, wr, wc, fr, fq);
        else if (cb < 512) tile<BJ, 0, LATT>(acc, u, wr, wc, fr, fq);
        else if (cb < 768) tile<BJ, 1, LATT>(acc, u, wr, wc, fr, fq);
        else if (cb < 1024) tile<BJ, 2, LATT>(acc, u, wr, wc, fr, fq);
        else if (cb < 1280) tile<BJ, 3, LATT>(acc, u, wr, wc, fr, fq);
        else if (cb < 1536) tile<BJ, 4, LATT>(acc, u, wr, wc, fr, fq);
        else if (cb < 1792) tile<BJ, 5, LATT>(acc, u, wr, wc, fr, fq);
        else if (cb < 2304) tile<BJ, 6, LATT>(acc, u, wr, wc, fr, fq);
        else if (cb < 2432) tile<BJ, 7, LATT>(acc, u, wr, wc, fr, fq);
        else if (cb < 2560) tile<BJ, 8, LATT>(acc, u, wr, wc, fr, fq);
        else tile<BJ, 9, LATT>(acc, u, wr, wc, fr, fq);
    }
    DI void operator()(const f32x4 (&acc)[2][2][4][2], const Unit& u, int wr, int wc, int fr_, int fq_) const {
        int fr = fr_, fq = fq_; asm volatile("" : "+v"(fr), "+v"(fq));
        if (u.pm >= 32) { tile_bj<0, true>(acc, u, wr, wc, fr, fq); tile_bj<1, true>(acc, u, wr, wc, fr, fq); }
        else { tile_bj<0, false>(acc, u, wr, wc, fr, fq); tile_bj<1, false>(acc, u, wr, wc, fr, fq); }
    }
};

struct EpiDft {
    static constexpr bool PERM = true, AFTER_DRAIN = false, HOOK = false;
    const bf16_t* FZ; bf16_t* Y; int tokbase, T;
    DI void operator()(const f32x4 (&acc)[2][2][4][2], const Unit& u, int wr, int wc, int fr_, int fq_) const {
        int fr = fr_, fq = fq_; asm volatile("" : "+v"(fr), "+v"(fq));
#pragma unroll
        for (int ai = 0; ai < 2; ++ai)
#pragma unroll
            for (int m = 0; m < 4; ++m) {
                const size_t tok = (size_t)tokbase + (size_t)u.pn * T + u.pm * 256 + ai * 128 + wr * 64 + m * 16 + fr;
#pragma unroll
                for (int bj = 0; bj < 2; ++bj) {
                    const int col = bj * 128 + wc * 32 + 8 * fq;
                    const u32x4 z = *(const u32x4*)(FZ + tok * 256 + col);
                    const f32x4 a0 = acc[ai][bj][m][0], a1 = acc[ai][bj][m][1];
                    u32x4 w; w.x = pk2(a0[0] * bflo(z.x), a0[1] * bfhi(z.x)); w.y = pk2(a0[2] * bflo(z.y), a0[3] * bfhi(z.y));
                    w.z = pk2(a1[0] * bflo(z.z), a1[1] * bfhi(z.z)); w.w = pk2(a1[2] * bflo(z.w), a1[3] * bfhi(z.w));
                    *(u32x4*)(Y + tok * 1024 + col) = w;
                }
            }
    }
};

struct EpiDftHalf {
    static constexpr bool PERM = true, AFTER_DRAIN = true, HOOK = false;
    const bf16_t* FZ; bf16_t* Y; bf16_t* PART; unsigned* cnt; int half;
    DI void fused(const f32x4 (&acc)[2][2][4][2], const Unit& u, int wr, int wc, int fr_, int fq_, LAS unsigned char* lds, int wid, int lane) const {
        int fr = fr_, fq = fq_; asm volatile("" : "+v"(fr), "+v"(fq));
        const int tid = wid * 64 + lane, tile = u.pn * 4 + u.pm;
        u32x2* mine = (u32x2*)PART + (size_t)(tile * 4 + half) * 32 * 512 + tid;
#pragma unroll
        for (int ai = 0; ai < 2; ++ai)
#pragma unroll
            for (int bj = 0; bj < 2; ++bj)
#pragma unroll
                for (int m = 0; m < 4; ++m)
#pragma unroll
                    for (int n = 0; n < 2; ++n) { const f32x4 a = acc[ai][bj][m][n]; mine[(size_t)((((ai * 2 + bj) * 4 + m) * 2 + n)) * 512] = (u32x2){pk2(a[0], a[1]), pk2(a[2], a[3])}; }
        asm volatile("s_waitcnt vmcnt(0)" ::: "memory");
        __syncthreads();
        volatile LAS unsigned* flag = (volatile LAS unsigned*)(lds + 64);
        if (tid == 0) {
            __builtin_amdgcn_fence(__ATOMIC_RELEASE, "agent"); asm volatile("s_waitcnt vmcnt(0)" ::: "memory");
            const unsigned old = __hip_atomic_fetch_add(cnt + tile, 1u, __ATOMIC_RELAXED, __HIP_MEMORY_SCOPE_AGENT);
            if (old == 3u) { __builtin_amdgcn_fence(__ATOMIC_ACQUIRE, "agent"); asm volatile("s_waitcnt vmcnt(0)" ::: "memory"); }
            flag[0] = old;
        }
        __syncthreads();
        if (flag[0] != 3u) return;
        const float sm = half < 2 ? 1.f : -1.f;
        const u32x2* o1p = (const u32x2*)PART + (size_t)(tile * 4 + ((half + 1) & 3)) * 32 * 512 + tid; const float s1 = ((half + 1) & 3) < 2 ? 1.f : -1.f;
        const u32x2* o2p = (const u32x2*)PART + (size_t)(tile * 4 + ((half + 2) & 3)) * 32 * 512 + tid; const float s2 = ((half + 2) & 3) < 2 ? 1.f : -1.f;
        const u32x2* o3p = (const u32x2*)PART + (size_t)(tile * 4 + ((half + 3) & 3)) * 32 * 512 + tid; const float s3 = ((half + 3) & 3) < 2 ? 1.f : -1.f;
#pragma unroll
        for (int ai = 0; ai < 2; ++ai)
#pragma unroll
            for (int m = 0; m < 4; ++m) {
                int k = u.pm * 256 + ai * 128 + wr * 64 + m * 16 + fr; asm volatile("" : "+v"(k));
                const size_t tok = (size_t)NCTX + (size_t)u.pn * 2048 + k;
                const size_t tokm = (size_t)NCTX + (size_t)u.pn * 2048 + (k ? 2048 - k : 0);
#pragma unroll
                for (int bj = 0; bj < 2; ++bj) {
                    const int col = bj * 128 + wc * 32 + 8 * fq;
                    const u32x4 z = *(const u32x4*)(FZ + tok * 256 + col);
                    const u32x4 zm = *(const u32x4*)(FZ + tokm * 256 + col);
                    f32x4 a[2], d[2];
#pragma unroll
                    for (int n = 0; n < 2; ++n) {
                        const size_t ix = (size_t)((((ai * 2 + bj) * 4 + m) * 2 + n)) * 512;
                        const u32x2 q1 = o1p[ix], q2 = o2p[ix], q3 = o3p[ix];
                        const f32x4 p1 = (f32x4){bflo(q1.x), bfhi(q1.x), bflo(q1.y), bfhi(q1.y)}, p2 = (f32x4){bflo(q2.x), bfhi(q2.x), bflo(q2.y), bfhi(q2.y)},
                                    p3 = (f32x4){bflo(q3.x), bfhi(q3.x), bflo(q3.y), bfhi(q3.y)};
                        a[n] = (acc[ai][bj][m][n] + p1) + (p2 + p3);
                        d[n] = (acc[ai][bj][m][n] * sm + p1 * s1) + (p2 * s2 + p3 * s3);
                    }
                    u32x4 w; w.x = pk2(a[0][0] * bflo(z.x), a[0][1] * bfhi(z.x)); w.y = pk2(a[0][2] * bflo(z.y), a[0][3] * bfhi(z.y));
                    w.z = pk2(a[1][0] * bflo(z.z), a[1][1] * bfhi(z.z)); w.w = pk2(a[1][2] * bflo(z.w), a[1][3] * bfhi(z.w));
                    *(u32x4*)(Y + tok * 1024 + col) = w;
                    if (k != 0) {
                        u32x4 wm; wm.x = pk2(d[0][0] * bflo(zm.x), d[0][1] * bfhi(zm.x)); wm.y = pk2(d[0][2] * bflo(zm.y), d[0][3] * bfhi(zm.y));
                        wm.z = pk2(d[1][0] * bflo(zm.z), d[1][1] * bfhi(zm.z)); wm.w = pk2(d[1][2] * bflo(zm.w), d[1][3] * bfhi(zm.w));
                        *(u32x4*)(Y + tokm * 1024 + col) = wm;
                    }
                }
                asm volatile("" ::: "memory");
            }
    }
};

struct EpiMerge {
    static constexpr bool PERM = true, AFTER_DRAIN = false, HOOK = true;
    const unsigned char* MG8; bf16_t* MERGED;
    DI void seg(f32x4 (&acc)[2][2][4][2], const Unit& u, int t, int wr, int wc, int fr_, int fq_) const {
        int fr = fr_, fq = fq_; asm volatile("" : "+v"(fr), "+v"(fq));
        const int which = (t == 4) ? 0 : 1;
#pragma unroll
        for (int ai = 0; ai < 2; ++ai)
#pragma unroll
            for (int m = 0; m < 4; ++m) {
                const size_t row = (size_t)u.pm * 256 + ai * 128 + wr * 64 + m * 16 + fr;
#pragma unroll
                for (int bj = 0; bj < 2; ++bj) {
                    const int col = u.pn * 256 + bj * 128 + wc * 32 + 8 * fq;
                    const u32x2 ga = *(const u32x2*)(MG8 + row * 3072 + which * 1024 + col);
                    const u32x2 gb = *(const u32x2*)(MG8 + row * 3072 + (which + 1) * 1024 + col);
#pragma unroll
                    for (int e = 0; e < 8; ++e) {
                        const unsigned wa = e < 4 ? ga.x : ga.y, wb = e < 4 ? gb.x : gb.y;
                        const float fa = (float)((wa >> (8 * (e & 3))) & 255u), fb = (float)((wb >> (8 * (e & 3))) & 255u);
                        acc[ai][bj][m][e >> 2][e & 3] *= fa * __builtin_amdgcn_rcpf(fb);
                    }
                }
            }
    }
    DI void operator()(const f32x4 (&acc)[2][2][4][2], const Unit& u, int wr, int wc, int fr_, int fq_) const {
        int fr = fr_, fq = fq_; asm volatile("" : "+v"(fr), "+v"(fq));
#pragma unroll
        for (int ai = 0; ai < 2; ++ai)
#pragma unroll
            for (int m = 0; m < 4; ++m) {
                const size_t row = (size_t)u.pm * 256 + ai * 128 + wr * 64 + m * 16 + fr;
#pragma unroll
                for (int bj = 0; bj < 2; ++bj) {
                    const int col = u.pn * 256 + bj * 128 + wc * 32 + 8 * fq;
                    const u32x2 gc = *(const u32x2*)(MG8 + row * 3072 + 2048 + col);
                    float r[8];
#pragma unroll
                    for (int e = 0; e < 8; ++e) { const unsigned wcw = e < 4 ? gc.x : gc.y; r[e] = acc[ai][bj][m][e >> 2][e & 3] * ((float)((wcw >> (8 * (e & 3))) & 255u) * (1.f / 255.f)); }
                    u32x4 w; w.x = pk2(r[0], r[1]); w.y = pk2(r[2], r[3]); w.z = pk2(r[4], r[5]); w.w = pk2(r[6], r[7]);
                    *(u32x4*)(MERGED + row * 1024 + col) = w;
                }
            }
    }
};

struct EpiOut {
    static constexpr bool PERM = true, AFTER_DRAIN = false, HOOK = false;
    bf16_t* OUT;
    DI void operator()(const f32x4 (&acc)[2][2][4][2], const Unit& u, int wr, int wc, int fr_, int fq_) const {
        int fr = fr_, fq = fq_; asm volatile("" : "+v"(fr), "+v"(fq));
#pragma unroll
        for (int ai = 0; ai < 2; ++ai)
#pragma unroll
            for (int m = 0; m < 4; ++m) {
                const size_t row = (size_t)u.pm * 256 + ai * 128 + wr * 64 + m * 16 + fr;
#pragma unroll
                for (int bj = 0; bj < 2; ++bj) {
                    const int col = u.pn * 256 + bj * 128 + wc * 32 + 8 * fq;
                    const f32x4 a0 = acc[ai][bj][m][0], a1 = acc[ai][bj][m][1];
                    u32x4 w; w.x = pk2(a0[0], a0[1]); w.y = pk2(a0[2], a0[3]); w.z = pk2(a1[0], a1[1]); w.w = pk2(a1[2], a1[3]);
                    *(u32x4*)(OUT + row * 1024 + col) = w;
                }
            }
    }
};

struct OneUnit {
    Unit u;
    DI bool next(int i, Unit& o) const { if (i != 0) return false; o = u; return true; }
    DI void a_ready(const Unit&) const {}
    DI void done(const Unit&) const {}
};

DI void phase0(const Params& p, LAS unsigned char* lds) {
    const int tid = threadIdx.x, G = gridDim.x, bid = blockIdx.x;
    const size_t gtid = (size_t)bid * 512 + tid, gsz = (size_t)G * 512;
    unsigned char* ws = p.ws;
    LAS float* ctab = (LAS float*)lds;
    LAS float* sc = (LAS float*)(lds + 8192);
    LAS float* red = (LAS float*)(lds + 8192 + 20480);
    for (int j = tid; j < 2048; j += 512) ctab[j] = cosf((float)j * (6.283185307179586f / 2048.f));
    for (int i = tid; i < 5120; i += 512) { const int v = i >> 10, k = i & 1023; const float x = v == 0 ? p.c_ctx[k] : p.c[(v - 1) * 1024 + k]; sc[i] = x / (1.f + expf(-x)); }
    __syncthreads();
    if (gtid < 16) { const float x = p.ret_decay[gtid]; ((float*)(ws + WS_LG2))[gtid] = -log1pf(expf(-x)) * LOG2E; }
    for (size_t i = gtid; i < 1024; i += gsz) { const int pos = (int)(i >> 4), k = (int)(i & 15); const float inv = powf(10000.f, -(float)k / 16.f), ang = (float)pos * inv;
        ((float*)(ws + WS_ROPE))[i] = cosf(ang); ((float*)(ws + WS_ROPE))[1024 + i] = sinf(ang); }
    for (size_t i = gtid; i < 4096; i += gsz) ((bf16_t*)(ws + WS_IDENT))[i] = ((i >> 6) == (i & 63)) ? (bf16_t)0x3F80 : (bf16_t)0;
    for (size_t i = gtid; i < (size_t)2 * 2 * 65536; i += gsz) {
        const int n = (int)(i & 255), r = (int)((i >> 8) & 255), x = (int)((i >> 16) & 1), l = (int)(i >> 17);
        const int grp = r >> 6, rr = r & 63; const float* wf = p.w_four + ((size_t)l * 256 + grp * 64) * 256 + n; float s = 0.f;
        for (int m = 0; m < 64; ++m) { const int a = (rr * m) & 63; const float tr = x == 0 ? ctab[a * 32] : ctab[((a * 32) - 512) & 2047]; s += tr * wf[(size_t)m * 256]; }
        ((float*)(ws + WS_W4))[i] = s * 0.125f;
    }
    for (int it = bid; it < 192; it += G) {
        const int l = it / 96, cg0 = (it % 96) * 32, ks = tid >> 5, col = tid & 31;
        float a[5] = {0.f, 0.f, 0.f, 0.f, 0.f};
        const float* wp = p.w_mod + ((size_t)l * 1024 + ks * 64) * 3072 + cg0 + col;
#pragma unroll 1
        for (int k8 = 0; k8 < 64; k8 += 8) { float wv[8];
#pragma unroll
            for (int q = 0; q < 8; ++q) wv[q] = wp[(size_t)(k8 + q) * 3072];
#pragma unroll
            for (int q = 0; q < 8; ++q)
#pragma unroll
                for (int v = 0; v < 5; ++v) a[v] += sc[v * 1024 + ks * 64 + k8 + q] * wv[q]; }
        __syncthreads();
#pragma unroll
        for (int v = 0; v < 5; ++v) red[(ks * 5 + v) * 32 + col] = a[v];
        __syncthreads();
        if (tid < 160) { const int v = tid >> 5; float s = 0.f;
#pragma unroll
            for (int k2 = 0; k2 < 16; ++k2) s += red[(k2 * 5 + v) * 32 + col];
            ((float*)(ws + WS_MOD))[((size_t)l * 5 + v) * 3072 + cg0 + col] = s + p.b_mod[(size_t)l * 3072 + cg0 + col]; }
    }
}

DI void phase0b(const Params& p, LAS unsigned char* lds) {
    int tid_l = threadIdx.x; asm volatile("" : "+v"(tid_l));
    const int tid = tid_l, G = gridDim.x, bid = blockIdx.x;
    const size_t gtid = (size_t)bid * 512 + tid, gsz = (size_t)G * 512;
    unsigned char* ws = p.ws;
    LAS float* ctab = (LAS float*)lds;
    __syncthreads();
    for (int j = tid; j < 2048; j += 512) ctab[j] = cosf((float)j * (6.283185307179586f / 2048.f));
    __syncthreads();
    for (size_t i = gtid; i < (size_t)256 * 512 / 8; i += gsz) {
        const int k = (int)(i >> 6), t0 = (int)(i & 63) * 8; unsigned w[4];
#pragma unroll
        for (int e = 0; e < 8; e += 2) { float v2[2];
#pragma unroll
            for (int q = 0; q < 2; ++q) { const int tp = t0 + e + q, seg = tp >> 8, t = tp & 255, a = ((k * t) & 255) * 8; v2[q] = (seg ? -ctab[(a - 512) & 2047] : ctab[a]) * 0.0625f; }
            w[e >> 1] = pk2(v2[0], v2[1]); }
        *(u32x4*)((bf16_t*)(ws + WS_TABC) + i * 8) = (u32x4){w[0], w[1], w[2], w[3]};
    }
    for (size_t i = gtid; i < (size_t)4 * 1024 * 1024 / 8; i += gsz) {
        const int part = (int)(i >> 17), k = (int)((i >> 7) & 1023), t0 = (int)(i & 127) * 8 + (part & 1) * 1024, seg = part >> 1; unsigned w[4];
#pragma unroll
        for (int e = 0; e < 8; e += 2) { float v2[2];
#pragma unroll
            for (int q = 0; q < 2; ++q) { const int t = t0 + e + q, a = (k * t) & 2047; v2[q] = (seg ? -ctab[(a - 512) & 2047] : ctab[a]) * 0.02209708691207961f; }
            w[e >> 1] = pk2(v2[0], v2[1]); }
        *(u32x4*)((bf16_t*)(ws + WS_TABL) + i * 8) = (u32x4){w[0], w[1], w[2], w[3]};
    }
    for (size_t i = gtid; i < (size_t)2 * 4 * 2 * 512 * 64; i += gsz) {
        const int d = (int)(i & 63), s = (int)((i >> 6) & 511), kvh = (int)((i >> 15) & 1), b = (int)((i >> 16) & 3), l = (int)(i >> 18);
        const size_t src = ((((size_t)b * 2 + l) * 512 + s) * 2 + kvh) * 64 + d;
        ((bf16_t*)(ws + WS_CKB))[i] = f2bf(p.cache_k[src]);
        ((bf16_t*)(ws + WS_CVT))[((((size_t)l * 4 + b) * 2 + kvh) * 64 + d) * 512 + s] = f2bf(p.cache_v[src]);
    }
    __syncthreads();
}

DI void transpose_item(const float* src, int ld_src, bf16_t* dst, int ld_dst, int k0, int n0src, int rowdst0, int kdst0, LAS float* scr, int lane) {
#pragma unroll 8
    for (int i = 0; i < 32; ++i) { const int kk = 2 * i + (lane >> 5); scr[kk * 33 + (lane & 31)] = src[(size_t)(k0 + kk) * ld_src + n0src + (lane & 31)]; }
    LDS_WAIT();
    const int c = lane & 7;
#pragma unroll
    for (int j = 0; j < 4; ++j) { const int n = (lane >> 3) + 8 * j; const LAS float* s = scr + (8 * c) * 33 + n;
        u32x4 o; o.x = pk2(s[0 * 33], s[1 * 33]); o.y = pk2(s[2 * 33], s[3 * 33]); o.z = pk2(s[4 * 33], s[5 * 33]); o.w = pk2(s[6 * 33], s[7 * 33]);
        *(u32x4*)(dst + (size_t)(rowdst0 + n) * ld_dst + kdst0 + 8 * c) = o; }
    LDS_WAIT();
}

DI void row_pass(const Params& p, int mode) {
    int tid_l = threadIdx.x; asm volatile("" : "+v"(tid_l));
    const int lane = tid_l & 63, wave = __builtin_amdgcn_readfirstlane(tid_l >> 6);
    const int gw = blockIdx.x * 8 + wave, NGW = gridDim.x * 8;
    const float* mod = (const float*)(p.ws + WS_MOD);
    for (int row0 = gw; row0 < NTOK; row0 += 2 * NGW) {
        f32x4 x[2][4], o[2][4];
#pragma unroll
        for (int rr = 0; rr < 2; ++rr) {
            const int row = row0 + rr * NGW;
            if (row < NTOK) {
                const bool lat = row >= NCTX;
                if (mode == 2) {
                    const bf16_t* xb = (const bf16_t*)(p.out + (size_t)row * 1024);
#pragma unroll
                    for (int j = 0; j < 4; ++j) { const u32x2 v = *(const u32x2*)(xb + 4 * lane + 256 * j); x[rr][j] = (f32x4){bflo(v.x), bfhi(v.x), bflo(v.y), bfhi(v.y)}; }
                } else {
                    const float* xin = lat ? p.x_sample + (size_t)(row - NCTX) * 1024 : p.x_prompt + (size_t)row * 1024;
#pragma unroll
                    for (int j = 0; j < 4; ++j) x[rr][j] = *(const f32x4*)(xin + 4 * lane + 256 * j);
                }
                if (mode != 0) {
                    const bf16_t* orow = (const bf16_t*)(p.ws + WS_OUT) + (size_t)row * 1024;
#pragma unroll
                    for (int j = 0; j < 4; ++j) { const u32x2 ob = *(const u32x2*)(orow + 4 * lane + 256 * j); o[rr][j] = (f32x4){bflo(ob.x), bfhi(ob.x), bflo(ob.y), bfhi(ob.y)}; }
                }
            }
        }
#pragma unroll
        for (int rr = 0; rr < 2; ++rr) {
            const int row = row0 + rr * NGW;
            if (row < NTOK) {
                const bool lat = row >= NCTX; const int vec = lat ? 1 + ((row - NCTX) >> 11) : 0;
                if (mode != 0) {
                    const int lp = mode - 1;
                    float s = 0.f;
#pragma unroll
                    for (int j = 0; j < 4; ++j) s += (o[rr][j][0] * o[rr][j][0] + o[rr][j][1] * o[rr][j][1]) + (o[rr][j][2] * o[rr][j][2] + o[rr][j][3] * o[rr][j][3]);
                    const float rstd = 1.f / sqrtf(wave_sum(s) * (1.f / 1024.f) + EPS);
#pragma unroll
                    for (int j = 0; j < 4; ++j) {
                        const f32x4 gp = *(const f32x4*)(p.g_post + (size_t)lp * 1024 + 4 * lane + 256 * j);
                        const f32x4 gt = *(const f32x4*)(mod + ((size_t)lp * 5 + vec) * 3072 + 2048 + 4 * lane + 256 * j);
                        x[rr][j] = x[rr][j] + gt * (o[rr][j] * rstd * gp);
                        if (mode == 2) *(f32x4*)(p.out + (size_t)row * 1024 + 4 * lane + 256 * j) = x[rr][j];
                        else { u32x2 w; w.x = pk2(x[rr][j][0], x[rr][j][1]); w.y = pk2(x[rr][j][2], x[rr][j][3]); *(u32x2*)((bf16_t*)(p.out + (size_t)row * 1024) + 4 * lane + 256 * j) = w; }
                    }
                }
                if (mode != 2) {
                    const int l = mode; float s = 0.f;
#pragma unroll
                    for (int j = 0; j < 4; ++j) s += (x[rr][j][0] * x[rr][j][0] + x[rr][j][1] * x[rr][j][1]) + (x[rr][j][2] * x[rr][j][2] + x[rr][j][3] * x[rr][j][3]);
                    const float rstd = 1.f / sqrtf(wave_sum(s) * (1.f / 1024.f) + EPS);
                    bf16_t* hrow = (bf16_t*)(p.ws + WS_H) + (size_t)row * 1024;
#pragma unroll
                    for (int j = 0; j < 4; ++j) {
                        const f32x4 g = *(const f32x4*)(p.g_pre + (size_t)l * 1024 + 4 * lane + 256 * j);
                        const f32x4 sh = *(const f32x4*)(mod + ((size_t)l * 5 + vec) * 3072 + 4 * lane + 256 * j);
                        const f32x4 scl = *(const f32x4*)(mod + ((size_t)l * 5 + vec) * 3072 + 1024 + 4 * lane + 256 * j);
                        const f32x4 hv = (x[rr][j] * rstd * g) * (scl + 1.f) + sh;
                        u32x2 w; w.x = pk2(hv[0], hv[1]); w.y = pk2(hv[2], hv[3]);
                        *(u32x2*)(hrow + 4 * lane + 256 * j) = w;
                    }
                }
            }
        }
    }
}

DI void weight_prep(const Params& p, LAS unsigned char* lds, bool do_fold, bool do_tr) {
    int tid_l = threadIdx.x; asm volatile("" : "+v"(tid_l));
    const int tid = tid_l, lane = tid & 63, wave = __builtin_amdgcn_readfirstlane(tid >> 6), G = gridDim.x;
    unsigned char* ws = p.ws;
    LAS float* sA = (LAS float*)lds; LAS float* sB = sA + 64 * 129;
    if (do_fold)
    for (int it0 = blockIdx.x; it0 < 256; it0 += G) {
        const int l = it0 >> 7, it = it0 & 127; bf16_t* WinT = (bf16_t*)(ws + WS_WINT + wl(l));
        const int dt = it >> 3, nt8 = it & 7, x = nt8 >> 2, n0 = (nt8 & 3) * 64;
        const float* W4 = (const float*)(ws + WS_W4) + ((size_t)l * 2 + x) * 65536;
        const float* wi = p.w_in + (size_t)l * 1024 * WIN_LD + (size_t)dt * 64 * WIN_LD;
        float a[8] = {0.f, 0.f, 0.f, 0.f, 0.f, 0.f, 0.f, 0.f};
        const int d = tid >> 3, ng = tid & 7;
        for (int half = 0; half < 2; ++half) {
            __syncthreads();
            for (int i = tid; i < 8192; i += 512) { const int dd = i >> 7, r = i & 127; sA[dd * 129 + r] = wi[(size_t)dd * WIN_LD + half * 128 + r]; }
            for (int i = tid; i < 8192; i += 512) { const int r = i >> 6, n = i & 63; sB[r * 64 + n] = W4[(size_t)(half * 128 + r) * 256 + n0 + n]; }
            __syncthreads();
            for (int r = 0; r < 128; ++r) { const float av = sA[d * 129 + r]; const LAS float* bp = sB + r * 64 + ng * 8;
#pragma unroll
                for (int e = 0; e < 8; ++e) a[e] += av * bp[e]; }
        }
#pragma unroll
        for (int e = 0; e < 8; ++e) WinT[(size_t)(x * 256 + n0 + ng * 8 + e) * 1024 + dt * 64 + d] = f2bf(a[e]);
    }
    __syncthreads();
    LAS float* scr = (LAS float*)(lds + wave * 8704);
    const int gw = blockIdx.x * 8 + wave, NGW = G * 8;
    if (do_tr)
    for (int it = gw; it < 7680; it += NGW) {
        const int l = it / 3840; int r = it % 3840; bf16_t* WinT = (bf16_t*)(ws + WS_WINT + wl(l));
        if (r < 2816) { const int kb = r / 176, nb = r % 176; const int lrow = 512 + 32 * nb, prow = colperm(lrow >> 8) * 256 + (lrow & 255); transpose_item(p.w_in + (size_t)l * 1024 * WIN_LD, WIN_LD, WinT, 1024, 64 * kb, 256 + 32 * nb, prow, 64 * kb, scr, lane); continue; } r -= 2816;
        if (r < 128) { const int kb = r >> 5, nb = r & 31; transpose_item(p.w_pa + (size_t)l * 256 * 1024, 1024, (bf16_t*)(ws + WS_WBRT + wl(l)), 1024, 64 * kb, 32 * nb, 32 * nb, 64 * kb, scr, lane); continue; } r -= 128;
        if (r < 128) { const int kb = r >> 5, nb = r & 31; transpose_item(p.w_pb + (size_t)l * 256 * 1024, 1024, (bf16_t*)(ws + WS_WBRT + wl(l)), 1024, 64 * kb, 32 * nb, 32 * nb, 256 + 64 * kb, scr, lane); continue; } r -= 128;
        if (r < 256) { const int kb = r >> 5, nb = r & 31; transpose_item(p.w_pc + (size_t)l * 512 * 1024, 1024, (bf16_t*)(ws + WS_WBRT + wl(l)), 1024, 64 * kb, 32 * nb, 32 * nb, 512 + 64 * kb, scr, lane); continue; } r -= 256;
        { const int kb = r >> 5, nb = r & 31; transpose_item(p.w_out + (size_t)l * 1024 * 1024, 1024, (bf16_t*)(ws + WS_WOUTT + wl(l)), 1024, 64 * kb, 32 * nb, 32 * nb, 64 * kb, scr, lane); }
    }
}

constexpr int FK_STRIDE = 144, FV_STRIDE = 136, FV_OFF = 64 * FK_STRIDE, FBUF = 64 * FK_STRIDE + 64 * FV_STRIDE;
struct TileSrc { const bf16_t* k; int kld; const bf16_t* vt; int vld; };

DI void flash_load(const TileSrc& s, u32x4& kr, u32x4& vr, int tid) {
    const int row = tid >> 3, ch = tid & 7;
    kr = *(const u32x4*)(s.k + (size_t)row * s.kld + ch * 8);
    vr = *(const u32x4*)(s.vt + (size_t)row * s.vld + ch * 8);
}
DI void flash_store(LAS unsigned char* buf, const u32x4& kr, const u32x4& vr, int tid) {
    const int row = tid >> 3, ch = tid & 7;
    *(LAS u32x4*)(buf + row * FK_STRIDE + ch * 16) = kr;
    LAS u32x2* vp = (LAS u32x2*)(buf + FV_OFF + row * FV_STRIDE + ch * 16);
    vp[0] = (u32x2){vr.x, vr.y}; vp[1] = (u32x2){vr.z, vr.w};
}
DI void flash_qk(const LAS unsigned char* buf, const bf16x8 (&qf)[4], f32x16& s0, f32x16& s1, int r32, int hh) {
#pragma unroll
    for (int kk = 0; kk < 4; ++kk) {
        const bf16x8 a0 = *(const LAS bf16x8*)(buf + r32 * FK_STRIDE + (16 * kk + 8 * hh) * 2);
        const bf16x8 a1 = *(const LAS bf16x8*)(buf + (32 + r32) * FK_STRIDE + (16 * kk + 8 * hh) * 2);
        s0 = MFMA32(a0, qf[kk], s0); s1 = MFMA32(a1, qf[kk], s1);
    }
}
DI void flash_kload(const LAS unsigned char* buf, bf16x8 (&a0)[4], bf16x8 (&a1)[4], int r32, int hh) {
#pragma unroll
    for (int kk = 0; kk < 4; ++kk) {
        a0[kk] = *(const LAS bf16x8*)(buf + r32 * FK_STRIDE + (16 * kk + 8 * hh) * 2);
        a1[kk] = *(const LAS bf16x8*)(buf + (32 + r32) * FK_STRIDE + (16 * kk + 8 * hh) * 2);
    }
}
DI void flash_qk_pre(const bf16x8 (&a0)[4], const bf16x8 (&a1)[4], const bf16x8 (&qf)[4], f32x16& s0, f32x16& s1) {
#pragma unroll
    for (int kk = 0; kk < 4; ++kk) { s0 = MFMA32(a0[kk], qf[kk], s0); s1 = MFMA32(a1[kk], qf[kk], s1); }
}
DI void flash_vload(const LAS unsigned char* buf, bf16x8 (&va)[4][2], int r32, int hh) {
#pragma unroll
    for (int s = 0; s < 4; ++s)
#pragma unroll
        for (int db = 0; db < 2; ++db) {
            const LAS unsigned char* vp = buf + FV_OFF + (32 * db + r32) * FV_STRIDE + (16 * s + 4 * hh) * 2;
            const u32x2 lo = *(const LAS u32x2*)vp, hi = *(const LAS u32x2*)(vp + 16);
            va[s][db] = __builtin_bit_cast(bf16x8, ((u32x4){lo.x, lo.y, hi.x, hi.y}));
        }
}
DI bf16x8 pack8(float a0, float a1, float a2, float a3, float a4, float a5, float a6, float a7) {
    u32x4 w; w.x = pk2(a0, a1); w.y = pk2(a2, a3); w.z = pk2(a4, a5); w.w = pk2(a6, a7); return __builtin_bit_cast(bf16x8, w);
}
DI void flash_pv_step(const LAS unsigned char* buf, int s, const bf16x8& pf, f32x16& o0, f32x16& o1, int r32, int hh) {
#pragma unroll
    for (int db = 0; db < 2; ++db) {
        const LAS unsigned char* vp = buf + FV_OFF + (32 * db + r32) * FV_STRIDE + (16 * s + 4 * hh) * 2;
        const u32x2 lo = *(const LAS u32x2*)vp, hi = *(const LAS u32x2*)(vp + 16);
        const bf16x8 va = __builtin_bit_cast(bf16x8, ((u32x4){lo.x, lo.y, hi.x, hi.y}));
        if (db == 0) o0 = MFMA32(va, pf, o0); else o1 = MFMA32(va, pf, o1);
    }
}
DI void flash_pv_pre(const bf16x8 (&va)[4][2], const f32x16& p0, const f32x16& p1, f32x16& o0, f32x16& o1) {
    const bf16x8 f0 = pack8(p0[0], p0[1], p0[2], p0[3], p0[4], p0[5], p0[6], p0[7]), f1 = pack8(p0[8], p0[9], p0[10], p0[11], p0[12], p0[13], p0[14], p0[15]);
    const bf16x8 f2 = pack8(p1[0], p1[1], p1[2], p1[3], p1[4], p1[5], p1[6], p1[7]), f3 = pack8(p1[8], p1[9], p1[10], p1[11], p1[12], p1[13], p1[14], p1[15]);
    o0 = MFMA32(va[0][0], f0, o0); o1 = MFMA32(va[0][1], f0, o1);
    o0 = MFMA32(va[1][0], f1, o0); o1 = MFMA32(va[1][1], f1, o1);
    o0 = MFMA32(va[2][0], f2, o0); o1 = MFMA32(va[2][1], f2, o1);
    o0 = MFMA32(va[3][0], f3, o0); o1 = MFMA32(va[3][1], f3, o1);
}
DI void flash_pv(const LAS unsigned char* buf, const f32x16& p0, const f32x16& p1, f32x16& o0, f32x16& o1, int r32, int hh) {
    flash_pv_step(buf, 0, pack8(p0[0], p0[1], p0[2], p0[3], p0[4], p0[5], p0[6], p0[7]), o0, o1, r32, hh);
    flash_pv_step(buf, 1, pack8(p0[8], p0[9], p0[10], p0[11], p0[12], p0[13], p0[14], p0[15]), o0, o1, r32, hh);
    flash_pv_step(buf, 2, pack8(p1[0], p1[1], p1[2], p1[3], p1[4], p1[5], p1[6], p1[7]), o0, o1, r32, hh);
    flash_pv_step(buf, 3, pack8(p1[8], p1[9], p1[10], p1[11], p1[12], p1[13], p1[14], p1[15]), o0, o1, r32, hh);
}

template <bool LAT>
DI void attn_unit(const Params& p, LAS unsigned char* lds, int layer, int b, int kvh, int qb) {
    constexpr int T = LAT ? 2048 : 256;
    int tid_l = threadIdx.x; asm volatile("" : "+v"(tid_l));
    const int tid = tid_l, w = __builtin_amdgcn_readfirstlane(tid >> 6), l = tid & 63, r32 = l & 31, hh = l >> 5;
    const unsigned char* ws = p.ws;
    const int tokbase = LAT ? NCTX + b * 2048 : b * 256;
    const int head = kvh * 4 + (w >> 1);
    const int myq = qb * 64 + (w & 1) * 32 + r32;
    bf16x8 qf[4];
    { const bf16_t* qp = (const bf16_t*)(ws + WS_AQ) + (size_t)(tokbase + myq) * 512 + head * 64 + 8 * hh;
#pragma unroll
      for (int kk = 0; kk < 4; ++kk) qf[kk] = *(const bf16x8*)(qp + 16 * kk); }
    float mrun = p.attn_sink[layer * 8 + head] * LOG2E;
    float lsum = hh == 0 ? 1.f : 0.f;
    f32x16 o0, o1;
#pragma unroll
    for (int i = 0; i < 16; ++i) { o0[i] = 0.f; o1[i] = 0.f; }
    int jlo = 0, nloc = 4;
    if (LAT) { jlo = qb < 2 ? 2 - qb : 0; int jhi = 33 - qb; if (jhi > 4) jhi = 4; nloc = jhi - jlo + 1; }
    const int ntile = LAT ? nloc + 8 : nloc;
    const bf16_t* AK = (const bf16_t*)(ws + WS_AK); const bf16_t* AVT = (const bf16_t*)(ws + WS_AVT) + (LAT ? (size_t)1024 * 1024 : 0);
    const bf16_t* CK = (const bf16_t*)(ws + WS_CKB) + (size_t)((layer * 4 + b) * 2 + kvh) * 512 * 64;
    const bf16_t* CV = (const bf16_t*)(ws + WS_CVT) + (size_t)((layer * 4 + b) * 2 + kvh) * 64 * 512;
    auto src_of = [&](int i, int& key0, bool& local) -> TileSrc {
        TileSrc s;
        if (i < nloc) { key0 = LAT ? qb * 64 - 128 + 64 * (jlo + i) : 64 * i; local = true;
            s.k = AK + (size_t)(tokbase + key0) * 128 + kvh * 64; s.kld = 128; s.vt = AVT + (size_t)((b * 2 + kvh) * 64) * T + key0; s.vld = T; }
        else { key0 = 64 * (i - nloc); local = false; s.k = CK + (size_t)key0 * 64; s.kld = 64; s.vt = CV + key0; s.vld = 512; }
        return s;
    };
    u32x4 kr, vr; int key0; bool local;
    { const TileSrc s = src_of(0, key0, local); flash_load(s, kr, vr, tid); flash_store(lds, kr, vr, tid); }
    for (int i = 0; i < ntile; ++i) {
        __syncthreads();
        const LAS unsigned char* buf = lds + (i & 1) * FBUF;
        int k0n; bool locn;
        if (i + 1 < ntile) { const TileSrc s = src_of(i + 1, k0n, locn); flash_load(s, kr, vr, tid); }
        { int kd; bool ld_; (void)src_of(i, kd, ld_); key0 = kd; local = ld_; }
        f32x16 s0, s1;
        { const float nm = -mrun;
#pragma unroll
          for (int r = 0; r < 16; ++r) { s0[r] = nm; s1[r] = nm; } }
        bf16x8 ka0[4], ka1[4]; flash_kload(buf, ka0, ka1, r32, hh);
        __builtin_amdgcn_sched_barrier(0);
        flash_qk_pre(ka0, ka1, qf, s0, s1);
        bf16x8 va[4][2]; flash_vload(buf, va, r32, hh);
        __builtin_amdgcn_sched_barrier(0);
        if (LAT && local && (jlo + i == 0 || jlo + i == 4)) {
#pragma unroll
            for (int r = 0; r < 16; ++r) { const int kp = key0 + crow(r, hh); int d0 = myq - kp; d0 = d0 < 0 ? -d0 : d0; int d1 = myq - kp - 32; d1 = d1 < 0 ? -d1 : d1;
                if (d0 > 128) s0[r] = -INFINITY; if (d1 > 128) s1[r] = -INFINITY; }
        }
        float mx = fmaxf(s0[0], s1[0]);
#pragma unroll
        for (int r = 1; r < 16; ++r) mx = fmaxf(fmaxf(mx, s0[r]), s1[r]);
        mx = fmaxf(mx, __shfl_xor(mx, 32));
        if (__builtin_amdgcn_ballot_w64(mx > 8.f) != 0ull) {
            const float inc = fmaxf(mx, 0.f), alpha = __builtin_amdgcn_exp2f(-inc);
            mrun += inc; lsum *= alpha; o0 = o0 * alpha; o1 = o1 * alpha;
            s0 = s0 - inc; s1 = s1 - inc;
        }
        float rs = 0.f;
#pragma unroll
        for (int r = 0; r < 16; ++r) { s0[r] = __builtin_amdgcn_exp2f(s0[r]); s1[r] = __builtin_amdgcn_exp2f(s1[r]); rs += s0[r] + s1[r]; }
        lsum += rs;
        flash_pv_pre(va, s0, s1, o0, o1);
        if (i + 1 < ntile) flash_store(lds + ((i + 1) & 1) * FBUF, kr, vr, tid);
    }
    const float ltot = lsum + __shfl_xor(lsum, 32), inv = 1.f / ltot;
    const bf16_t* AZ = (const bf16_t*)(ws + WS_AZ) + (size_t)(tokbase + myq) * 512 + head * 64;
    bf16_t* Y = (bf16_t*)(p.ws + WS_H) + (size_t)(tokbase + myq) * 1024 + 512 + head * 64;
#pragma unroll
    for (int db = 0; db < 2; ++db)
#pragma unroll
        for (int g4 = 0; g4 < 4; ++g4) {
            const int d = 32 * db + 8 * g4 + 4 * hh;
            const u32x2 z = *(const u32x2*)(AZ + d);
            const f32x16& o = db == 0 ? o0 : o1;
            u32x2 wv; wv.x = pk2(o[4 * g4] * inv * bflo(z.x), o[4 * g4 + 1] * inv * bfhi(z.x)); wv.y = pk2(o[4 * g4 + 2] * inv * bflo(z.y), o[4 * g4 + 3] * inv * bfhi(z.y));
            *(u32x2*)(Y + d) = wv;
        }
}

template <bool LAT>
DI void ret_unit(const Params& p, LAS unsigned char* lds, int layer, int b, int h, int qb, unsigned* flag) {
    constexpr int T = LAT ? 2048 : 256;
    int tid_l = threadIdx.x; asm volatile("" : "+v"(tid_l));
    const int tid = tid_l, w = __builtin_amdgcn_readfirstlane(tid >> 6), l = tid & 63, r32 = l & 31, hh = l >> 5;
    const unsigned char* ws = p.ws; asm volatile("" : "+s"(ws));
    const int tokbase = LAT ? NCTX + b * 2048 : b * 256;
    const int myq = qb * 256 + w * 32 + r32;
    const float* lg2 = (const float*)(ws + WS_LG2);
    const float lf = lg2[layer * 8 + h], lb = lg2[layer * 8 + 4 + h];
    bf16x8 qf[4];
    { const bf16_t* qp = (const bf16_t*)(ws + WS_RQ) + (size_t)(tokbase + myq) * 256 + h * 64 + 8 * hh;
#pragma unroll
      for (int kk = 0; kk < 4; ++kk) qf[kk] = *(const bf16x8*)(qp + 16 * kk); }
    f32x16 o0, o1;
#pragma unroll
    for (int i = 0; i < 16; ++i) { o0[i] = 0.f; o1[i] = 0.f; }
    f32x16 cf, cbk;
#pragma unroll
    for (int r = 0; r < 16; ++r) { cf[r] = __builtin_amdgcn_exp2f(-(float)crow(r, hh) * lf); cbk[r] = __builtin_amdgcn_exp2f((float)crow(r, hh) * lb); }
    const float g32f = __builtin_amdgcn_exp2f(-32.f * lf), g32b = __builtin_amdgcn_exp2f(32.f * lb);
    constexpr int nreal = 4;
    const int ntile = LAT ? nreal + 2 : nreal;
    if (LAT) {
        if (tid == 0) { unsigned sp = 0; while (__hip_atomic_load(flag, __ATOMIC_RELAXED, __HIP_MEMORY_SCOPE_AGENT) < 2u) { __builtin_amdgcn_s_sleep(4); if (++sp > (1u << 22)) break; }
            __builtin_amdgcn_fence(__ATOMIC_ACQUIRE, "agent"); asm volatile("s_waitcnt vmcnt(0)" ::: "memory"); }
        __syncthreads();
    }
    const bf16_t* RK = (const bf16_t*)(ws + WS_RK) + (size_t)tokbase * 256 + h * 64;
    const bf16_t* RVT = (const bf16_t*)(ws + WS_RVT) + (LAT ? (size_t)2 * 1024 * 1024 : 0) + (size_t)((b * 4 + h) * 64) * T;
    const bf16_t* ID = (const bf16_t*)(ws + WS_IDENT);
    const bf16_t* S0 = (const bf16_t*)(ws + WS_SCH) + (size_t)((((b * 4 + h) * 8 + qb) * 2)) * 4096;
    auto src_of = [&](int i) -> TileSrc {
        TileSrc s;
        if (i < nreal) { s.k = RK + (size_t)(qb * 256 + 64 * i) * 256; s.kld = 256; s.vt = RVT + qb * 256 + 64 * i; s.vld = T; }
        else { s.k = ID; s.kld = 64; s.vt = S0 + (size_t)(i - nreal) * 4096; s.vld = 64; }
        return s;
    };
    u32x4 kr, vr;
    { const TileSrc s = src_of(0); flash_load(s, kr, vr, tid); flash_store(lds, kr, vr, tid); }
    for (int i = 0; i < ntile; ++i) {
        __syncthreads();
        const LAS unsigned char* buf = lds + (i & 1) * FBUF;
        if (i + 1 < ntile) { const TileSrc s = src_of(i + 1); flash_load(s, kr, vr, tid); }
        f32x16 s0, s1;
#pragma unroll
        for (int r = 0; r < 16; ++r) { s0[r] = 0.f; s1[r] = 0.f; }
        flash_qk(buf, qf, s0, s1, r32, hh);
        if (i < nreal) {
            const int key0 = qb * 256 + 64 * i, qw = qb * 256 + w * 32;
            if (key0 + 63 < qw) {
                const float E = __builtin_amdgcn_exp2f((float)(myq - key0) * lf);
                s0 = s0 * cf * E; s1 = s1 * cf * (E * g32f);
            } else if (key0 > qw + 31) {
                const float E = __builtin_amdgcn_exp2f((float)(key0 - myq) * lb);
                s0 = s0 * cbk * E; s1 = s1 * cbk * (E * g32b);
            } else {
                const int dq = myq - key0;
                const float Ef = __builtin_amdgcn_exp2f((float)dq * lf), Eb = __builtin_amdgcn_exp2f(-(float)dq * lb);
                const f32x16 vf0 = cf * Ef, vb0 = cbk * Eb, vf1 = cf * (Ef * g32f), vb1 = cbk * (Eb * g32b);
#pragma unroll
                for (int r = 0; r < 16; ++r) {
                    const int d0 = dq - crow(r, hh), d1 = d0 - 32;
                    const float f0 = d0 > 0 ? vf0[r] : (d0 < 0 ? vb0[r] : 2.f);
                    const float f1 = d1 > 0 ? vf1[r] : (d1 < 0 ? vb1[r] : 2.f);
                    s0[r] *= f0; s1[r] *= f1;
                }
            }
        } else {
            const int pl = w * 32 + r32;
            const float f = (i == nreal) ? __builtin_amdgcn_exp2f((float)(pl + 1) * lf) : __builtin_amdgcn_exp2f((float)(256 - pl) * lb);
#pragma unroll
            for (int r = 0; r < 16; ++r) { s0[r] *= f; s1[r] *= f; }
        }
        flash_pv(buf, s0, s1, o0, o1, r32, hh);
        if (i + 1 < ntile) flash_store(lds + ((i + 1) & 1) * FBUF, kr, vr, tid);
    }
    float ss = 0.f;
#pragma unroll
    for (int r = 0; r < 16; ++r) ss += o0[r] * o0[r] + o1[r] * o1[r];
    ss += __shfl_xor(ss, 32);
    const float rstd = 1.f / sqrtf(ss * (1.f / 64.f) + EPS);
    const float* gn = p.ret_gn + (size_t)layer * 256 + h * 64;
    const bf16_t* RZ = (const bf16_t*)(ws + WS_RZ) + (size_t)(tokbase + myq) * 256 + h * 64;
    bf16_t* Y = (bf16_t*)(p.ws + WS_H) + (size_t)(tokbase + myq) * 1024 + 256 + h * 64;
#pragma unroll
    for (int db = 0; db < 2; ++db)
#pragma unroll
        for (int g4 = 0; g4 < 4; ++g4) {
            const int e = 32 * db + 8 * g4 + 4 * hh;
            const u32x2 z = *(const u32x2*)(RZ + e);
            const f32x4 g = *(const f32x4*)(gn + e);
            const f32x16& o = db == 0 ? o0 : o1;
            u32x2 wv; wv.x = pk2(o[4 * g4] * rstd * g[0] * bflo(z.x), o[4 * g4 + 1] * rstd * g[1] * bfhi(z.x));
            wv.y = pk2(o[4 * g4 + 2] * rstd * g[2] * bflo(z.y), o[4 * g4 + 3] * rstd * g[3] * bfhi(z.y));
            *(u32x2*)(Y + e) = wv;
        }
    if (!LAT) {
        const int dir = w >> 2, dblk = (w >> 1) & 1, eblk = w & 1;
        const bf16_t* A = (const bf16_t*)(ws + (dir ? WS_RKTB : WS_RKTF)) + (size_t)((b * 4 + h) * 64 + 32 * dblk + r32) * 256 + 8 * hh;
        const bf16_t* B = (const bf16_t*)(ws + WS_RVT) + (size_t)((b * 4 + h) * 64 + 32 * eblk + r32) * 256 + 8 * hh;
        f32x16 acc;
#pragma unroll
        for (int r = 0; r < 16; ++r) acc[r] = 0.f;
#pragma unroll 4
        for (int s = 0; s < 16; ++s) { const bf16x8 a = *(const bf16x8*)(A + 16 * s), bb = *(const bf16x8*)(B + 16 * s); acc = MFMA32(a, bb, acc); }
        float* o = p.out + O_ST + (size_t)((((b * 2 + layer) * 2 + dir) * 4 + h)) * 4096;
#pragma unroll
        for (int r = 0; r < 16; ++r) o[(32 * dblk + crow(r, hh)) * 64 + 32 * eblk + r32] = acc[r];
    }
}

DI void ret_state_job(const Params& p, LAS unsigned char* lds, int layer, int b, int h, int dir, unsigned* flag) {
    int tid_l = threadIdx.x; asm volatile("" : "+v"(tid_l));
    const int tid = tid_l, w = __builtin_amdgcn_readfirstlane(tid >> 6), l = tid & 63, r32 = l & 31, hh = l >> 5;
    const unsigned char* ws = p.ws; asm volatile("" : "+s"(ws));
    const int dblk = (w >> 1) & 1, eblk = w & 1;
    const float g256 = __builtin_amdgcn_exp2f(256.f * ((const float*)(ws + WS_LG2))[layer * 8 + dir * 4 + h]);
    f32x16 S;
    { const float* s0 = p.state_ret + ((size_t)((((b * 2 + layer) * 2 + dir) * 4 + h)) * 64) * 64;
#pragma unroll
      for (int r = 0; r < 16; ++r) S[r] = s0[(32 * dblk + crow(r, hh)) * 64 + 32 * eblk + r32]; }
    const bf16_t* Ag = (const bf16_t*)(ws + (dir ? WS_RKTBL : WS_RKTFL)) + (size_t)((b * 4 + h) * 64) * 2048;
    const bf16_t* Bg = (const bf16_t*)(ws + WS_RVT) + (size_t)2 * 1024 * 1024 + (size_t)((b * 4 + h) * 64) * 2048;
    bf16_t* SCH = (bf16_t*)(p.ws + WS_SCH) + (size_t)((b * 4 + h) * 8) * 2 * 4096;
    constexpr int RST = 528;
#pragma unroll 1
    for (int it = 0; it < 8; ++it) {
        const int c = dir ? 7 - it : it;
        __syncthreads();
#pragma unroll
        for (int q = 0; q < 8; ++q) {
            const int idx = tid + 512 * q, img = idx >> 11, rem = idx & 2047, row = rem >> 5, pc = rem & 31;
            const u32x4 v = *(const u32x4*)((img ? Bg : Ag) + (size_t)row * 2048 + c * 256 + pc * 8);
            *(LAS u32x4*)(lds + img * 64 * RST + row * RST + pc * 16) = v;
        }
        __syncthreads();
        if (w < 4) {
            { bf16_t* o = SCH + (size_t)(c * 2 + dir) * 4096 + (size_t)(32 * eblk + r32) * 64 + 32 * dblk + 4 * hh;
#pragma unroll
              for (int g4 = 0; g4 < 4; ++g4) { u32x2 wv; wv.x = pk2(S[4 * g4], S[4 * g4 + 1]); wv.y = pk2(S[4 * g4 + 2], S[4 * g4 + 3]); *(u32x2*)(o + 8 * g4) = wv; } }
            f32x16 acc;
#pragma unroll
            for (int r = 0; r < 16; ++r) acc[r] = 0.f;
            const LAS unsigned char* ap = lds + (32 * dblk + r32) * RST + 16 * hh;
            const LAS unsigned char* bp = lds + 64 * RST + (32 * eblk + r32) * RST + 16 * hh;
#pragma unroll
            for (int s = 0; s < 16; ++s) { const bf16x8 a = *(const LAS bf16x8*)(ap + 32 * s), bb = *(const LAS bf16x8*)(bp + 32 * s); acc = MFMA32(a, bb, acc); }
            S = S * g256 + acc;
        }
    }
    asm volatile("s_waitcnt vmcnt(0)" ::: "memory");
    __syncthreads();
    if (tid == 0) { __builtin_amdgcn_fence(__ATOMIC_RELEASE, "agent"); asm volatile("s_waitcnt vmcnt(0)" ::: "memory");
        __hip_atomic_fetch_add(flag, 1u, __ATOMIC_RELAXED, __HIP_MEMORY_SCOPE_AGENT); }
}

DI void dft_nyquist_job(const Params& p, int b) {
    int tid_l = threadIdx.x; asm volatile("" : "+v"(tid_l));
    const int tid = tid_l, w = __builtin_amdgcn_readfirstlane(tid >> 6), l = tid & 63;
    const bf16_t* U = (const bf16_t*)(p.ws + WS_UTL) + (size_t)(b * 256) * 1024;
    const size_t tok = (size_t)NCTX + (size_t)b * 2048 + 1024;
    const bf16_t* FZ = (const bf16_t*)(p.ws + WS_FZ) + tok * 256; bf16_t* Y = (bf16_t*)(p.ws + WS_H) + tok * 1024;
#pragma unroll 1
    for (int c = 0; c < 32; ++c) {
        const int ch = w * 32 + c; float s = 0.f;
#pragma unroll
        for (int q = 0; q < 4; ++q) { const u32x4 v = *(const u32x4*)(U + (size_t)((q >> 1) * 1024 + ch) * 1024 + (q & 1) * 512 + l * 8);
            s += (bflo(v.x) - bfhi(v.x)) + (bflo(v.y) - bfhi(v.y)) + (bflo(v.z) - bfhi(v.z)) + (bflo(v.w) - bfhi(v.w)); }
        s = wave_sum(s);
        if (l == 0) Y[ch] = f2bf(s * 0.02209708691207961f * bflo((unsigned)FZ[ch]));
    }
}

DI void mixer_phase(const Params& p, LAS unsigned char* lds, int slot) {
    const int layer = slot & 1;
    unsigned* ctr = (unsigned*)(p.ws + WS_CTL) + 64 * slot;
    volatile LAS int* bc = (volatile LAS int*)(lds + LDS_RING);
    const int tid = threadIdx.x;
    for (;;) {
        __syncthreads();
        if (tid == 0) bc[0] = (int)atomicAdd(ctr, 1u);
        __syncthreads();
        const int u = bc[0];
        if (u >= 900) break;
        unsigned* sflag = (unsigned*)(p.ws + WS_CTL) + 768 + 16 * slot;
        if (u < 32) { ret_state_job(p, lds, layer, u >> 3, (u >> 1) & 3, u & 1, sflag + (u >> 1)); }
        else if (u < 96) {
            const int v = u - 32, part = v & 3, tile = v >> 2;
            pg8::Gemm g; OneUnit S; EpiDftHalf E;
            g.A = (const bf16_t*)(p.ws + WS_TABL) + (size_t)part * 1024 * 1024; g.Bt = (const bf16_t*)(p.ws + WS_UTL) + (size_t)part * 1024 * 1024; g.M = 1024; g.N = 1024; g.K = 1024;
            S.u.pm = tile & 3; S.u.pn = tile >> 2;
            E.FZ = (const bf16_t*)(p.ws + WS_FZ); E.Y = (bf16_t*)(p.ws + WS_H); E.PART = (bf16_t*)(p.ws + WS_PART); E.cnt = (unsigned*)(p.ws + WS_CTL) + 256 + 32 * slot; E.half = part;
            pg8::gemm_phase<EpiDftHalf, OneUnit, false, true>(lds, g, S, E);
        } else if (u < 100) { dft_nyquist_job(p, u - 96); }
        else if (u >= 484 && u < 516) {
            const int i = u - 484;
            pg8::Gemm g; OneUnit S; EpiDft E;
            E.FZ = (const bf16_t*)(p.ws + WS_FZ); E.Y = (bf16_t*)(p.ws + WS_H);
            g.A = (const bf16_t*)(p.ws + WS_TABC); g.Bt = (const bf16_t*)(p.ws + WS_UTC); g.M = 256; g.N = 8192; g.K = 512; S.u.pm = 0; S.u.pn = i; E.tokbase = 0; E.T = 256;
            pg8::gemm_phase<EpiDft, OneUnit, false, true>(lds, g, S, E);
        } else if (u < 356) { const int i = u - 100; attn_unit<true>(p, lds, layer, i >> 6, (i >> 5) & 1, i & 31); }
        else if (u < 484) { const int i = u - 356; ret_unit<false>(p, lds, layer, i >> 2, i & 3, 0, nullptr); }
        else if (u < 772) { const int i = u - 516; attn_unit<false>(p, lds, layer, i >> 3, (i >> 2) & 1, i & 3); }
        else { const int i = u - 772; ret_unit<true>(p, lds, layer, i >> 5, (i >> 3) & 3, i & 7, sflag + (i >> 3)); }
    }
}

#define RLX_AGENT __ATOMIC_RELAXED, __HIP_MEMORY_SCOPE_AGENT
#define XB_TMO      128
#define XB_XCNT(j)  (256  + 64 * (j))
#define XB_XSUB(j)  (1280 + 64 * (j))
#define XB_XGEN(j)  (2304 + 64 * (j))
#define XB_TOP      3328
#define XB_TOPGEN   3392
#define XCD_BAR_WORDS 3456
#define XB_SPIN_CAP (1u << 18)

__device__ __forceinline__ unsigned xb_ld(unsigned* p)              { return __hip_atomic_load(p, __ATOMIC_RELAXED, __HIP_MEMORY_SCOPE_AGENT); }
__device__ __forceinline__ unsigned xb_add(unsigned* p, unsigned v) { return __hip_atomic_fetch_add(p, v, __ATOMIC_RELAXED, __HIP_MEMORY_SCOPE_AGENT); }
__device__ __forceinline__ unsigned xb_xcc_id() { return (unsigned)__builtin_amdgcn_s_getreg((3 << 11) | 20) & 0xFu; }
#define XB_SPIN(cond, bar) do { unsigned _sp = 0; while (cond) { __builtin_amdgcn_s_sleep(1); \
    if ((++_sp & 255u) == 0u) { if (xb_ld(&(bar)[XB_TMO])) break; if (_sp > XB_SPIN_CAP) { atomicAdd(&(bar)[XB_TMO], 1u); break; } } } } while (0)

struct XcdBarrier {
    unsigned* bar; unsigned x;
    volatile LAS unsigned* st;
};

__device__ __forceinline__ XcdBarrier xcd_barrier_post(unsigned* bar, volatile LAS unsigned* st) {
    XcdBarrier b; b.bar = bar; b.x = xb_xcc_id(); b.st = st;
    if (threadIdx.x == 0) (void)xb_add(&bar[XB_XCNT(b.x)], 1u);
    return b;
}
__device__ __forceinline__ void xcd_barrier_complete(unsigned* bar, unsigned x, unsigned& nloc, unsigned& nx) {
    const unsigned G = gridDim.x * gridDim.y * gridDim.z;
    unsigned sum, cnt, mine, sp = 0u;
    for (;;) {
        sum = 0u; cnt = 0u; mine = 0u;
#pragma unroll
        for (unsigned j = 0; j < 16; ++j) { const unsigned c = xb_ld(&bar[XB_XCNT(j)]); sum += c; cnt += (c > 0u) ? 1u : 0u; mine = (j == x) ? c : mine; }
        if (sum == G) break;
        __builtin_amdgcn_s_sleep(1);
        if ((++sp & 255u) == 0u) { if (xb_ld(&bar[XB_TMO])) break; if (sp > XB_SPIN_CAP) { atomicAdd(&bar[XB_TMO], 1u); break; } }
    }
    nloc = mine > 0u ? mine : 1u; nx = cnt > 0u ? cnt : 1u;
}

__device__ __forceinline__ void xcd_barrier(const XcdBarrier& b) {
    asm volatile("s_waitcnt vmcnt(0)" ::: "memory");
    __syncthreads();
    if (threadIdx.x == 0) {
        unsigned* bar = b.bar;
        __builtin_amdgcn_s_waitcnt(0);
        unsigned nloc = b.st[0], nx = b.st[1];
        if (nloc == 0u) { xcd_barrier_complete(bar, b.x, nloc, nx); b.st[0] = nloc; b.st[1] = nx; }
        const unsigned old = xb_add(&bar[XB_XSUB(b.x)], 1u);
        const unsigned gen = old / nloc;
        if (old + 1u == (gen + 1u) * nloc) {
            __builtin_amdgcn_fence(__ATOMIC_RELEASE, "agent");
            asm volatile("s_waitcnt vmcnt(0)" ::: "memory");
            const unsigned og = xb_add(&bar[XB_TOP], 1u);
            const unsigned tg = og / nx;
            if (og + 1u == (tg + 1u) * nx) xb_add(&bar[XB_TOPGEN], 1u);
            else XB_SPIN(xb_ld(&bar[XB_TOPGEN]) == tg, bar);
            __builtin_amdgcn_fence(__ATOMIC_ACQUIRE, "agent");
            xb_add(&bar[XB_XGEN(b.x)], 1u);
            asm volatile("s_waitcnt vmcnt(0)" ::: "memory");
        } else {
            XB_SPIN(xb_ld(&bar[XB_XGEN(b.x)]) == gen, bar);
            __builtin_amdgcn_fence(__ATOMIC_ACQUIRE, "agent");
            asm volatile("s_waitcnt vmcnt(0)" ::: "memory");
        }
    }
    __syncthreads();
}

__global__ void __launch_bounds__(512, 2) fwd_kernel(Params p) {
    extern __shared__ __attribute__((aligned(16))) unsigned char lds_raw[];
    LAS unsigned char* lds = (LAS unsigned char*)lds_raw;
    cg::grid_group grid = cg::this_grid();
    const int lo = p.ph_lo, hi = p.ph_hi, G = gridDim.x;
#define IN(k) (lo <= (k) && (k) < hi)
#ifndef PHMASK
#define PHMASK 0x7f
#endif
#define PH_ON(k) ((PHMASK >> (k)) & 1)
#ifndef REPMASK
#define REPMASK 0
#endif
#define REP_ON(k) ((REPMASK >> (k)) & 1)
    { volatile LAS unsigned* z = (volatile LAS unsigned*)(lds + LDS_RING); if (threadIdx.x < 32) z[threadIdx.x] = 0u; }
    __syncthreads();
    XcdBarrier bar = xcd_barrier_post((unsigned*)(p.ws + WS_CTL) + 1024, (volatile LAS unsigned*)(lds + LDS_RING + 64));
    if (lo < 0) grid.sync();
#define SEAM(k) do { if (IN(k) && IN((k) + 1)) xcd_barrier(bar); } while (0)
#pragma unroll 1
    for (int rep = 0; rep < 1 + 2 * REP_ON(0); ++rep)
    if (PH_ON(0) && IN(0)) { phase0(p, lds); }
    SEAM(0);
#pragma unroll 1
    for (int l = 0; l < 2; ++l) {
        const int pb = 1 + 5 * l;
#pragma unroll 1
        for (int rep = 0; rep < 1 + REP_ON(1); ++rep)
        if (PH_ON(1) && IN(pb)) { if (l == 0) { weight_prep(p, lds, true, true); phase0b(p, lds); } row_pass(p, l); }
        SEAM(pb);
#pragma unroll 1
        for (int rep = 0; rep < 1 + REP_ON(2); ++rep)
        if (PH_ON(2) && IN(pb + 1)) {
            pg8::Gemm g{(const bf16_t*)(p.ws + WS_H), (const bf16_t*)(p.ws + WS_WINT + wl(l)), NTOK, NWIN, DM}; pg8::StaticOrder S; S.init(NTOK, NWIN, G, (int)blockIdx.x);
            EpiIn E{p.ws, p.out, (const float*)(p.ws + WS_LG2), l, lds + LDS_STAGE};
            pg8::gemm_phase<EpiIn, pg8::StaticOrder, true, true>(lds, g, S, E);
        }
        SEAM(pb + 1);
#pragma unroll 1
        for (int rep = 0; rep < 1 + REP_ON(3); ++rep)
        if (PH_ON(3) && IN(pb + 2)) mixer_phase(p, lds, l + 2 * rep);
        SEAM(pb + 2);
#pragma unroll 1
        for (int rep = 0; rep < 1 + REP_ON(4); ++rep)
        if (PH_ON(4) && IN(pb + 3)) {
            pg8::Gemm g{(const bf16_t*)(p.ws + WS_H), (const bf16_t*)(p.ws + WS_WBRT + wl(l)), NTOK, DM, DM}; pg8::StaticOrder S; S.init(NTOK, DM, G, (int)blockIdx.x);
            EpiMerge E{p.ws + WS_MG8, (bf16_t*)(p.ws + WS_MERGED)};
            pg8::gemm_phase<EpiMerge, pg8::StaticOrder, false, true>(lds, g, S, E);
        }
        SEAM(pb + 3);
#pragma unroll 1
        for (int rep = 0; rep < 1 + REP_ON(5); ++rep)
        if (PH_ON(5) && IN(pb + 4)) {
            pg8::Gemm g{(const bf16_t*)(p.ws + WS_MERGED), (const bf16_t*)(p.ws + WS_WOUTT + wl(l)), NTOK, DM, DM}; pg8::StaticOrder S; S.init(NTOK, DM, G, (int)blockIdx.x);
            EpiOut E{(bf16_t*)(p.ws + WS_OUT)};
            pg8::gemm_phase<EpiOut, pg8::StaticOrder, false, true>(lds, g, S, E);
        }
        SEAM(pb + 4);
#pragma unroll 1
        for (int rep = 0; rep < 5 * REP_ON(7); ++rep) xcd_barrier(bar);
    }
    if (PH_ON(6) && IN(11)) row_pass(p, 2);
#undef IN
#undef SEAM
}

extern "C" void kernel_launch(void* const* d_in, const int* in_sizes, int n_in, void* d_out, int out_size, void* d_ws, size_t ws_size, hipStream_t stream) {
    static int grid = 0;
    if (grid == 0) {
        int dev = 0, cus = 0, per_cu = 0;
        if (n_in != 20 || ws_size < WS_END) { fprintf(stderr, "kernel_launch: unexpected inputs (n_in %d, ws %zu)\n", n_in, ws_size); grid = -1; return; }
        hipGetDevice(&dev);
        hipDeviceGetAttribute(&cus, hipDeviceAttributeMultiprocessorCount, dev);
        if (hipFuncSetAttribute((const void*)fwd_kernel, hipFuncAttributeMaxDynamicSharedMemorySize, LDS_BYTES) != hipSuccess) { fprintf(stderr, "kernel_launch: hipFuncSetAttribute failed\n"); grid = -1; return; }
        if (hipOccupancyMaxActiveBlocksPerMultiprocessor(&per_cu, (const void*)fwd_kernel, 512, LDS_BYTES) != hipSuccess || per_cu < 1) { fprintf(stderr, "kernel_launch: occupancy query says %d\n", per_cu); per_cu = 1; }
        (void)hipGetLastError();
        grid = cus * per_cu;
    }
    if (grid < 0) return;
    hipMemsetAsync((char*)d_ws + WS_CTL, 0, CTL_BYTES, stream);
    Params p{};
    const float** f = (const float**)&p;
    for (int i = 0; i < 20; ++i) f[i] = (const float*)d_in[i];
    p.out = (float*)d_out; p.ws = (unsigned char*)d_ws; p.ph_lo = 0; p.ph_hi = 12;
    void* args[] = {&p};
    const hipError_t e = hipLaunchCooperativeKernel((const void*)fwd_kernel, dim3(grid), dim3(512), args, LDS_BYTES, stream);
    if (e != hipSuccess) fprintf(stderr, "kernel_launch: cooperative launch failed: %s (grid %d)\n", hipGetErrorString(e), grid);
}
```
